# Optimizing an MI355X kernel written in HIP

```python
import math
import jax, jax.numpy as jnp
from jax import lax
import numpy as np

D_MODEL = 1024
BATCH = 8
SEQ = 2048
DEPTH = 1

D_MIX = D_MODEL
ATT_HEADS = 4
ATT_QK_DIM = 64
ATT_V_DIM = 2 * ATT_QK_DIM
ATT_QK_WIDTH = ATT_HEADS * 2 * ATT_QK_DIM
ATT_WIDTH = ATT_HEADS * ATT_V_DIM
N_BUCKETS = 32
MAX_DISTANCE = 128
Q_BLOCK = 128
SSD_WIDTH = D_MIX - ATT_WIDTH
SSD_HEADDIM = 64
SSD_HEADS = SSD_WIDTH // SSD_HEADDIM
SSD_GROUPS = 2
SSD_STATE = 64
SSD_CONV = 5
SSD_CHUNK = 128
SSD_CONV_CH = SSD_WIDTH + 2 * SSD_GROUPS * SSD_STATE
IN_SPLITS = (ATT_QK_WIDTH, ATT_QK_WIDTH, ATT_WIDTH, SSD_WIDTH, SSD_CONV_CH, SSD_HEADS, SSD_HEADS)
IN_COLS = 2 * ATT_QK_WIDTH + ATT_WIDTH + SSD_WIDTH + SSD_CONV_CH + 2 * SSD_HEADS
N_EXPERTS = 16
CAPACITY_FACTOR = 2
EXPERT_FF = 2816
EPS = 1e-6

kernel_name = 'hybrid_diffattn_ssd_ec_moe_block'


def lambda_init(layer):
    return 0.8 - 0.6 * math.exp(-0.3 * layer)


def rmsnorm(x, g):
    xf = x.astype(jnp.float32)
    xf = xf * lax.rsqrt(jnp.mean(xf * xf, axis=-1, keepdims=True) + EPS)
    return (xf * g.astype(jnp.float32)).astype(x.dtype)


def modulate(h, shift, scale):
    return h * (1.0 + scale[:, None, :]) + shift[:, None, :]


def t5_bucket(rel):
    nb = N_BUCKETS // 2
    ret = jnp.where(rel > 0, nb, 0)
    n = jnp.abs(rel)
    max_exact = nb // 2
    nf = jnp.maximum(n, 1).astype(jnp.float32)
    large = max_exact + (jnp.log(nf / max_exact) / math.log(MAX_DISTANCE / max_exact)
                         * (nb - max_exact)).astype(jnp.int32)
    large = jnp.minimum(large, nb - 1)
    return ret + jnp.where(n < max_exact, n, large)


def diff_attention(q, k, v, lam, rel_table):
    b, s = q.shape[:2]
    nblk = s // Q_BLOCK
    scale = ATT_QK_DIM ** -0.5
    qb = q.reshape(b, nblk, Q_BLOCK, ATT_HEADS, 2, ATT_QK_DIM).transpose(1, 0, 2, 3, 4, 5)
    k_pos = jnp.arange(s)

    def block(args):
        i, qi = args
        q_pos = i * Q_BLOCK + jnp.arange(Q_BLOCK)
        bucket = t5_bucket(k_pos[None, :] - q_pos[:, None])
        bias = rel_table[bucket].transpose(2, 0, 1).astype(jnp.float32)
        logits = jnp.einsum('bqhmd,bkhmd->bhmqk', qi, k).astype(jnp.float32) * scale
        probs = jax.nn.softmax(logits + bias[None, :, None], axis=-1)
        w = probs[:, :, 0] - lam * probs[:, :, 1]
        return jnp.einsum('bhqk,bkhd->bqhd', w.astype(v.dtype), v)

    out = lax.map(block, (jnp.arange(nblk), qb))
    return out.transpose(1, 0, 2, 3, 4).reshape(b, s, ATT_HEADS, ATT_V_DIM)


def segsum(x):
    t = x.shape[-1]
    cs = jnp.cumsum(x, axis=-1)
    seg = cs[..., :, None] - cs[..., None, :]
    mask = jnp.tril(jnp.ones((t, t), dtype=bool))
    return jnp.where(mask, seg, -jnp.inf)


def ssd_chunked(xs, dt, A, Bm, Cm):
    b, s = xs.shape[:2]
    nc = s // SSD_CHUNK
    r = SSD_HEADS // SSD_GROUPS
    X = (xs * dt[..., None]).reshape(b, nc, SSD_CHUNK, SSD_GROUPS, r, SSD_HEADDIM)
    dA = (dt * A).reshape(b, nc, SSD_CHUNK, SSD_GROUPS, r).transpose(0, 3, 4, 1, 2)
    Bc = Bm.reshape(b, nc, SSD_CHUNK, SSD_GROUPS, SSD_STATE)
    Cc = Cm.reshape(b, nc, SSD_CHUNK, SSD_GROUPS, SSD_STATE)
    A_cs = jnp.cumsum(dA, axis=-1)
    L = jnp.exp(segsum(dA))
    y_diag = jnp.einsum('bclgn,bcsgn,bgrcls,bcsgrp->bclgrp', Cc, Bc, L, X)
    decay_states = jnp.exp(A_cs[..., -1:] - A_cs)
    states = jnp.einsum('bclgn,bgrcl,bclgrp->bcgrpn', Bc, decay_states, X)
    states = jnp.concatenate([jnp.zeros_like(states[:, :1]), states], axis=1)
    decay_chunk = jnp.exp(segsum(jnp.pad(A_cs[..., -1], ((0, 0), (0, 0), (0, 0), (1, 0)))))
    new_states = jnp.einsum('bgrzc,bcgrpn->bzgrpn', decay_chunk, states)[:, :-1]
    y_off = jnp.einsum('bclgn,bcgrpn,bgrcl->bclgrp', Cc, new_states, jnp.exp(A_cs))
    return (y_diag + y_off).reshape(b, s, SSD_HEADS, SSD_HEADDIM)


def ssd_mixer(z, xbc, dt_f_raw, dt_b_raw, conv_w, conv_b, dt_bias_f, dt_bias_b,
              A_log_f, A_log_b, D_skip, norm_g):
    b, s = z.shape[:2]
    f32 = jnp.float32
    xbc = lax.conv_general_dilated(xbc, conv_w, window_strides=(1,),
                                   padding=((SSD_CONV // 2, SSD_CONV // 2),),
                                   dimension_numbers=('NWC', 'WIO', 'NWC'),
                                   feature_group_count=SSD_CONV_CH) + conv_b
    xbc = jax.nn.silu(xbc.astype(f32))
    xs, Bm, Cm = jnp.split(xbc, [SSD_WIDTH, SSD_WIDTH + SSD_GROUPS * SSD_STATE], axis=-1)
    xs = xs.reshape(b, s, SSD_HEADS, SSD_HEADDIM)
    Bm = Bm.reshape(b, s, SSD_GROUPS, SSD_STATE)
    Cm = Cm.reshape(b, s, SSD_GROUPS, SSD_STATE)
    dt_f = jax.nn.softplus(dt_f_raw.astype(f32) + dt_bias_f.astype(f32))
    dt_b = jax.nn.softplus(dt_b_raw.astype(f32) + dt_bias_b.astype(f32))
    A_f = -jnp.exp(A_log_f.astype(f32))
    A_b = -jnp.exp(A_log_b.astype(f32))
    rev = lambda t: jnp.flip(t, axis=1)
    y_f = ssd_chunked(xs, dt_f, A_f, Bm, Cm)
    y_b = rev(ssd_chunked(rev(xs), rev(dt_b), A_b, rev(Bm), rev(Cm)))
    y = y_f + y_b + D_skip.astype(f32)[:, None] * xs
    y = y.reshape(b, s, SSD_WIDTH) * jax.nn.silu(z.astype(f32))
    yg = y.reshape(b, s, SSD_GROUPS, SSD_WIDTH // SSD_GROUPS)
    yg = yg * lax.rsqrt(jnp.mean(yg * yg, axis=-1, keepdims=True) + EPS)
    return (yg.reshape(b, s, SSD_WIDTH) * norm_g.astype(f32)).astype(z.dtype)


def expert_choice_ffn(h, router_w, w_gate, w_up, w_down):
    b, s, d = h.shape
    cap = CAPACITY_FACTOR * s // N_EXPERTS
    aff = jax.nn.softmax(jnp.einsum('bsd,de->bse', h, router_w).astype(jnp.float32), axis=-1)
    g, idx = lax.top_k(aff.transpose(0, 2, 1), cap)
    bidx = jnp.arange(b)[:, None, None]
    xg = h[bidx, idx]
    hid = jax.nn.silu(jnp.einsum('becd,edf->becf', xg, w_gate)) * jnp.einsum('becd,edf->becf', xg, w_up)
    y = jnp.einsum('becf,efd->becd', hid, w_down) * g[..., None].astype(h.dtype)
    return jnp.zeros_like(h).at[bidx, idx].add(y)


def setup_inputs(seed: int = 0) -> dict:
    key = jax.random.key(seed)
    ks = jax.random.split(key, 32)
    f32 = jnp.float32

    def nrm(k, shape, s):
        return jax.random.normal(k, shape, f32) * s

    def gain(k, shape):
        return 1.0 + 0.02 * jax.random.normal(k, shape, f32)

    def dt_bias(k):
        dt = jnp.exp(jax.random.uniform(k, (DEPTH, SSD_HEADS), f32, math.log(1e-3), math.log(1e-1)))
        return dt + jnp.log(-jnp.expm1(-dt))

    return {
        'x': nrm(ks[0], (BATCH, SEQ, D_MODEL), 1.0),
        'c': nrm(ks[1], (BATCH, D_MODEL), 1.0),
        'ada_w': nrm(ks[2], (DEPTH, D_MODEL, 6 * D_MODEL), D_MODEL ** -0.5),
        'ada_b': nrm(ks[3], (DEPTH, 6 * D_MODEL), 0.02),
        'norm_mix_g': gain(ks[4], (DEPTH, D_MODEL)),
        'norm_ffn_g': gain(ks[5], (DEPTH, D_MODEL)),
        'norm_final_g': gain(ks[6], (D_MODEL,)),
        'w_in': nrm(ks[7], (DEPTH, D_MODEL, IN_COLS), D_MODEL ** -0.5),
        'lambda_q1': nrm(ks[8], (DEPTH, ATT_QK_DIM), 0.1),
        'lambda_k1': nrm(ks[9], (DEPTH, ATT_QK_DIM), 0.1),
        'lambda_q2': nrm(ks[10], (DEPTH, ATT_QK_DIM), 0.1),
        'lambda_k2': nrm(ks[11], (DEPTH, ATT_QK_DIM), 0.1),
        'attn_subln_g': gain(ks[12], (DEPTH, ATT_V_DIM)),
        'rel_bias_table': nrm(ks[13], (N_BUCKETS, ATT_HEADS), 0.5),
        'conv_w': nrm(ks[14], (DEPTH, SSD_CONV, 1, SSD_CONV_CH), SSD_CONV ** -0.5),
        'conv_b': nrm(ks[15], (DEPTH, SSD_CONV_CH), 0.02),
        'dt_bias_f': dt_bias(ks[16]),
        'dt_bias_b': dt_bias(ks[17]),
        'A_log_f': jnp.log(jax.random.uniform(ks[18], (DEPTH, SSD_HEADS), f32, 1.0, 16.0)),
        'A_log_b': jnp.log(jax.random.uniform(ks[19], (DEPTH, SSD_HEADS), f32, 1.0, 16.0)),
        'D_skip': gain(ks[20], (DEPTH, SSD_HEADS)),
        'ssm_norm_g': gain(ks[21], (DEPTH, SSD_WIDTH)),
        'w_out': nrm(ks[22], (DEPTH, D_MIX, D_MODEL), D_MIX ** -0.5),
        'router_w': nrm(ks[23], (DEPTH, D_MODEL, N_EXPERTS), D_MODEL ** -0.5),
        'w_gate': nrm(ks[24], (DEPTH, N_EXPERTS, D_MODEL, EXPERT_FF), D_MODEL ** -0.5),
        'w_up': nrm(ks[25], (DEPTH, N_EXPERTS, D_MODEL, EXPERT_FF), D_MODEL ** -0.5),
        'w_down': nrm(ks[26], (DEPTH, N_EXPERTS, EXPERT_FF, D_MODEL), EXPERT_FF ** -0.5),
    }


def reference(x, c, ada_w, ada_b, norm_mix_g, norm_ffn_g, norm_final_g, w_in,
              lambda_q1, lambda_k1, lambda_q2, lambda_k2, attn_subln_g, rel_bias_table,
              conv_w, conv_b, dt_bias_f, dt_bias_b, A_log_f, A_log_b, D_skip, ssm_norm_g,
              w_out, router_w, w_gate, w_up, w_down):
    b, s, _ = x.shape
    offs = np.cumsum(IN_SPLITS)[:-1].tolist()
    for l in range(DEPTH):
        lam_init = lambda_init(l)
        mod = jnp.einsum('bd,de->be', jax.nn.silu(c), ada_w[l]) + ada_b[l]
        sh1, sc1, g1, sh2, sc2, g2 = jnp.split(mod, 6, axis=-1)
        h = modulate(rmsnorm(x, norm_mix_g[l]), sh1, sc1)
        p = jnp.einsum('bsd,de->bse', h, w_in[l])
        q, k, v, z, xbc, dt_f, dt_b = jnp.split(p, offs, axis=-1)
        lam = (jnp.exp(jnp.sum(lambda_q1[l] * lambda_k1[l]).astype(jnp.float32))
               - jnp.exp(jnp.sum(lambda_q2[l] * lambda_k2[l]).astype(jnp.float32)) + lam_init)
        att = diff_attention(q.reshape(b, s, ATT_HEADS, 2, ATT_QK_DIM),
                             k.reshape(b, s, ATT_HEADS, 2, ATT_QK_DIM),
                             v.reshape(b, s, ATT_HEADS, ATT_V_DIM), lam, rel_bias_table)
        att = (rmsnorm(att, attn_subln_g[l]) * (1.0 - lam_init)).reshape(b, s, ATT_WIDTH)
        ssd = ssd_mixer(z, xbc, dt_f, dt_b, conv_w[l], conv_b[l], dt_bias_f[l], dt_bias_b[l],
                        A_log_f[l], A_log_b[l], D_skip[l], ssm_norm_g[l])
        mix = jnp.einsum('bsm,md->bsd', jnp.concatenate([att, ssd], axis=-1), w_out[l])
        x = x + g1[:, None, :] * mix
        h2 = modulate(rmsnorm(x, norm_ffn_g[l]), sh2, sc2)
        x = x + g2[:, None, :] * expert_choice_ffn(h2, router_w[l], w_gate[l], w_up[l], w_down[l])
    return rmsnorm(x, norm_final_g)
```

```cpp
#include <hip/hip_runtime.h>
#include <hip/hip_bf16.h>
#include <cstdio>
#include <cstdint>
#include <cmath>

#ifndef MK_N_LAUNCHES
#define MK_N_LAUNCHES 1
#endif

namespace pg8 {
#define PG8_LAS __attribute__((address_space(3)))
typedef unsigned short bf16_t;
typedef short bf16x8 __attribute__((ext_vector_type(8)));
typedef float f32x4 __attribute__((ext_vector_type(4)));
typedef unsigned u32x4 __attribute__((ext_vector_type(4)));
constexpr int BM = 256, BK = 64, HALF = 128, HTB = HALF * BK * 2  , STAGE_BYTES = 8 * HTB, NXCD = 8, WGM = 8;

__host__ __device__ __forceinline__ int lds_byte(int r, int c) { const int st = (r >> 4) * 2 + (c >> 5), rr = r & 15, cc = c & 31, ob = rr * 64 + cc * 2; return st * 1024 + (ob ^ (((ob >> 9) & 1) << 5)); }
__host__ __device__ __forceinline__ void stage_rc(int b, int& R, int& C) { const int st = b / 1024, sb = b % 1024, swz = sb ^ (((sb >> 9) & 1) << 5); R = (st >> 1) * 16 + swz / 64; C = (st & 1) * 32 + (swz % 64) / 2; }
__host__ __device__ __forceinline__ int perm32(int rho) { const int n = rho >> 4, i = rho & 15; return 8 * (i >> 2) + 4 * n + (i & 3); }

struct Unit { int pm, pn; };
struct Gemm { const void* A; const void* Bt; int KB; };

struct StaticOrder {
    int nM, nN, nwg, G, c;
    __host__ __device__ void init(int M, int N, int G_, int c_) { nM = M / BM; nN = N / BM; nwg = nM * nN; G = G_; c = c_; }
    __host__ __device__ bool next(int i, Unit& u) const {
        const long L = (long)i * G + c; if (L >= nwg) return false;
        int wgid = (int)L; { const int q = nwg / NXCD, r = nwg % NXCD, xcd = wgid % NXCD, off = wgid / NXCD; wgid = (xcd < r ? xcd * (q + 1) : r * (q + 1) + (xcd - r) * q) + off; }
        const int nig = WGM * nN, gid = wgid / nig, fm = gid * WGM, gsz = (nM - fm) < WGM ? (nM - fm) : WGM;
        u.pm = fm + ((wgid % nig) % gsz); u.pn = (wgid % nig) / gsz; return true;
    }
};
template <int NJ> struct MoeOrder {
    int G, v;
    __device__ bool next(int i, Unit& u) const {
        if (G == 256) {
            const int x = v >> 5, s = v & 31, b = s & 7, q = s >> 3, gi = 4 * i + q;
            if (gi >= 2 * NJ) return false;
            const int e = 2 * x + gi / NJ, j = gi % NJ; u.pm = e * 8 + b; u.pn = e * NJ + j; return true;
        } else {
            const long L = (long)i * G + v; if (L >= 16L * NJ * 8) return false;
            const int b = (int)(L & 7), gi = (int)(L >> 3), e = gi / NJ, j = gi % NJ; u.pm = e * 8 + b; u.pn = e * NJ + j; return true;
        }
    }
};
struct ARowDense { static constexpr bool GATHER = false; __device__ __forceinline__ unsigned row(const Unit& u, int r) const { return (unsigned)(u.pm * BM + r); } };
struct ARowDenseVO { static constexpr bool GATHER = true; __device__ __forceinline__ unsigned row(const Unit& u, int r) const { return (unsigned)(u.pm * BM + r); } };
struct ARowGather { static constexpr bool GATHER = true; const int* idx; __device__ __forceinline__ unsigned row(const Unit& u, int r) const { return (unsigned)idx[u.pm * BM + r]; } };

__device__ __forceinline__ unsigned cvt_pk_bf16(float lo, float hi) { unsigned r; asm volatile("v_cvt_pk_bf16_f32 %0, %1, %2" : "=v"(r) : "v"(lo), "v"(hi)); return r; }

struct EpiP {
    static constexpr bool PERM = true;
    bf16_t* O; int ldc; int nscale; float scale0; float* dtraw;
    __device__ __forceinline__ void operator()(const f32x4 (&acc)[2][2][4][2], const Unit& u, int wr, int wc, int fr, int fq) const {
        const int row0 = u.pm * BM + wr * 64 + fr, col0 = u.pn * BM + wc * 32 + 8 * fq;
        if (u.pn == 11) {
            if (wc == 0 && fq < 2) {
#pragma unroll
                for (int ai = 0; ai < 2; ++ai)
#pragma unroll
                    for (int m = 0; m < 4; ++m) { float* dp = dtraw + (size_t)(row0 + ai * HALF + m * 16) * 16 + 8 * fq; *(f32x4*)dp = acc[ai][0][m][0]; *(f32x4*)(dp + 4) = acc[ai][0][m][1]; } }
            return; }
        const float sc = (u.pn < nscale) ? scale0 : 1.f;
#pragma unroll
        for (int ai = 0; ai < 2; ++ai)
#pragma unroll
            for (int m = 0; m < 4; ++m) { bf16_t* rowp = O + (size_t)(row0 + ai * HALF + m * 16) * ldc + col0;
#pragma unroll
                for (int bj = 0; bj < 2; ++bj) { const f32x4 v0 = acc[ai][bj][m][0] * sc, v1 = acc[ai][bj][m][1] * sc;
                    u32x4 w; w.x = cvt_pk_bf16(v0[0], v0[1]); w.y = cvt_pk_bf16(v0[2], v0[3]); w.z = cvt_pk_bf16(v1[0], v1[1]); w.w = cvt_pk_bf16(v1[2], v1[3]);
                    *(u32x4*)(rowp + bj * HALF) = w; } }
    }
};
struct EpiX1 {
    static constexpr bool PERM = true;
    const float* x; bf16_t* out; const float* mod;
    __device__ __forceinline__ void operator()(const f32x4 (&acc)[2][2][4][2], const Unit& u, int wr, int wc, int fr, int fq) const {
        const int row0 = u.pm * BM + wr * 64 + fr, col0 = u.pn * BM + wc * 32 + 8 * fq;
        const float* g1 = mod + (size_t)((u.pm * BM) >> 11) * 6144 + 2048;
        f32x4 gv[2][2];
#pragma unroll
        for (int bj = 0; bj < 2; ++bj)
#pragma unroll
            for (int n = 0; n < 2; ++n) gv[bj][n] = *(const f32x4*)(g1 + col0 + bj * HALF + n * 4);
#pragma unroll
        for (int ai = 0; ai < 2; ++ai)
#pragma unroll
            for (int m = 0; m < 4; ++m) { const size_t off = (size_t)(row0 + ai * HALF + m * 16) * 1024 + col0;
#pragma unroll
                for (int bj = 0; bj < 2; ++bj) { const f32x4 x0 = __builtin_nontemporal_load((const f32x4*)(x + off + bj * HALF)), x1v = __builtin_nontemporal_load((const f32x4*)(x + off + bj * HALF + 4));
                    const f32x4 v0 = x0 + gv[bj][0] * acc[ai][bj][m][0], v1 = x1v + gv[bj][1] * acc[ai][bj][m][1];
                    u32x4 w; w.x = cvt_pk_bf16(v0[0], v0[1]); w.y = cvt_pk_bf16(v0[2], v0[3]); w.z = cvt_pk_bf16(v1[0], v1[1]); w.w = cvt_pk_bf16(v1[2], v1[3]);
                    *(u32x4*)(out + off + bj * HALF) = w; } }
    }
};
__device__ __forceinline__ float silu_f(float v) { return v * __builtin_amdgcn_rcpf(1.f + __builtin_amdgcn_exp2f(-1.4426950408889634f * v)); }
typedef unsigned u32x2 __attribute__((ext_vector_type(2)));
__device__ __forceinline__ unsigned pk_fp8x4(float a, float b, float c, float d) { unsigned w = 0u; w = __builtin_amdgcn_cvt_pk_fp8_f32(a, b, w, false); w = __builtin_amdgcn_cvt_pk_fp8_f32(c, d, w, true); return w; }
constexpr float WSCALE = 64.f, WSCALE_INV = 1.f / 64.f;
struct EpiHid {
    static constexpr bool PERM = true;
    unsigned char* O;
    __device__ __forceinline__ void operator()(const f32x4 (&acc)[2][2][4][2], const Unit& u, int wr, int wc, int fr, int fq) const {
        const int row0 = u.pm * BM + wr * 64 + fr, col0 = (u.pn % 22) * HALF + wc * 32 + 8 * fq;
#pragma unroll
        for (int ai = 0; ai < 2; ++ai)
#pragma unroll
            for (int m = 0; m < 4; ++m) { unsigned char* rowp = O + (size_t)(row0 + ai * HALF + m * 16) * 2816 + col0;
                f32x4 h0, h1;
#pragma unroll
                for (int i = 0; i < 4; ++i) { h0[i] = silu_f(acc[ai][0][m][0][i] * WSCALE_INV) * (acc[ai][1][m][0][i] * WSCALE_INV); h1[i] = silu_f(acc[ai][0][m][1][i] * WSCALE_INV) * (acc[ai][1][m][1][i] * WSCALE_INV); }
                u32x2 w; w.x = pk_fp8x4(h0[0], h0[1], h0[2], h0[3]); w.y = pk_fp8x4(h1[0], h1[1], h1[2], h1[3]);
                *(u32x2*)rowp = w; }
    }
};
struct EpiY {
    static constexpr bool PERM = true;
    unsigned char* O; const float* gate;
    __device__ __forceinline__ void operator()(const f32x4 (&acc)[2][2][4][2], const Unit& u, int wr, int wc, int fr, int fq) const {
        const int row0 = u.pm * BM + wr * 64 + fr, col0 = (u.pn & 3) * BM + wc * 32 + 8 * fq;
#pragma unroll
        for (int ai = 0; ai < 2; ++ai)
#pragma unroll
            for (int m = 0; m < 4; ++m) { const int row = row0 + ai * HALF + m * 16; const float gt = gate[row]; unsigned char* rowp = O + (size_t)row * 1024 + col0;
#pragma unroll
                for (int bj = 0; bj < 2; ++bj) { const f32x4 v0 = acc[ai][bj][m][0] * gt, v1 = acc[ai][bj][m][1] * gt;
                    u32x2 w; w.x = pk_fp8x4(v0[0], v0[1], v0[2], v0[3]); w.y = pk_fp8x4(v1[0], v1[1], v1[2], v1[3]);
                    *(u32x2*)(rowp + bj * HALF) = w; }
                asm volatile("" ::: "memory"); }
    }
};

typedef int v4i_t __attribute__((ext_vector_type(4)));
typedef int v8i_t __attribute__((ext_vector_type(8)));
template <bool FP8> struct FragT;
template <> struct FragT<false> { struct A4 { bf16x8 v[4][2]; }; struct B2 { bf16x8 v[2][2]; }; };
template <> struct FragT<true>  { struct A4 { v8i_t v[4]; };    struct B2 { v8i_t v[2]; }; };
template <class Epi, class Sched, class ARow, bool ALIGN_EPI, bool FP8>
__device__ __forceinline__ void gemm_phase(PG8_LAS unsigned char* lds, const Gemm g, const Sched& S, const Epi& E, const ARow& AR) {
    constexpr bool GATHER = ARow::GATHER;
    const int tid = threadIdx.x, wid = __builtin_amdgcn_readfirstlane(tid >> 6), lane = tid & 63, wr = wid >> 2, wc = wid & 3, fr = lane & 15, fq = lane >> 4;
    const int KB = g.KB, nt = KB / 128;
    int pR[2], pC[2]; unsigned voffA[2], voffB[2];
#pragma unroll
    for (int i = 0; i < 2; ++i) { int R, C; stage_rc(tid * 16 + i * 8192, R, C); const int Rb = Epi::PERM ? ((R & ~31) + perm32(R & 31)) : R;
        pR[i] = R; pC[i] = C; voffA[i] = (unsigned)(R * KB + C * 2); voffB[i] = (unsigned)(Rb * KB + C * 2); }
    const size_t kstep = (size_t)(BK * 2);
    const size_t hstep = (size_t)HALF * KB;
    const size_t tstep = 2 * hstep;
    const unsigned ldsw = (unsigned)wid * 1024u;
    const int aoff = lds_byte(wr * 64 + fr, fq * 8), boff = lds_byte(wc * 32 + fr, fq * 8);
#define PG8_SA(b, h) (((b) * 2 + (h)) * HTB)
#define PG8_SB(b, h) ((4 + (b) * 2 + (h)) * HTB)
#define PG8_STAGE(bufoff, gbase, voff) do { _Pragma("unroll") for (int _i = 0; _i < 2; ++_i) \
        __builtin_amdgcn_global_load_lds((const unsigned*)((const char*)(gbase) + (voff)[_i]), (PG8_LAS unsigned*)(lds + (bufoff) + ldsw + _i * 8192), 16, 0, 0); } while (0)
#define PG8_STAGE_A(bufoff, kp, h) do { if constexpr (GATHER) { _Pragma("unroll") for (int _i = 0; _i < 2; ++_i) \
        __builtin_amdgcn_global_load_lds((const unsigned*)((const char*)(kp) + voAc[h][_i]), (PG8_LAS unsigned*)(lds + (bufoff) + ldsw + _i * 8192), 16, 0, 0); } \
        else { PG8_STAGE(bufoff, (kp) + (h) * hstep, voffA); } } while (0)
#define PG8_LD16(off) (*(const PG8_LAS v4i_t*)(lds + (off)))
#define PG8_LDA(dst, b, h) do { _Pragma("unroll") for (int m = 0; m < 4; ++m) { \
        if constexpr (FP8) { dst.v[m] = __builtin_shufflevector(PG8_LD16(PG8_SA(b, h) + aoff + m * 2048), PG8_LD16(PG8_SA(b, h) + aoff + m * 2048 + 1024), 0, 1, 2, 3, 4, 5, 6, 7); } \
        else { _Pragma("unroll") for (int k = 0; k < 2; ++k) dst.v[m][k] = *(const PG8_LAS bf16x8*)(lds + PG8_SA(b, h) + aoff + m * 2048 + k * 1024); } } } while (0)
#define PG8_LDB(dst, b, h) do { _Pragma("unroll") for (int n = 0; n < 2; ++n) { \
        if constexpr (FP8) { dst.v[n] = __builtin_shufflevector(PG8_LD16(PG8_SB(b, h) + boff + n * 2048), PG8_LD16(PG8_SB(b, h) + boff + n * 2048 + 1024), 0, 1, 2, 3, 4, 5, 6, 7); } \
        else { _Pragma("unroll") for (int k = 0; k < 2; ++k) dst.v[n][k] = *(const PG8_LAS bf16x8*)(lds + PG8_SB(b, h) + boff + n * 2048 + k * 1024); } } } while (0)
#define PG8_MMA(ai, bj, At, Bt) do { __builtin_amdgcn_s_setprio(1); _Pragma("unroll") for (int m = 0; m < 4; ++m) _Pragma("unroll") for (int n = 0; n < 2; ++n) { \
        if constexpr (FP8) { acc[ai][bj][m][n] = __builtin_amdgcn_mfma_scale_f32_16x16x128_f8f6f4(Bt.v[n], At.v[m], acc[ai][bj][m][n], 0, 0, 0, 0x7f7f7f7f, 0, 0x7f7f7f7f); } \
        else { _Pragma("unroll") for (int k = 0; k < 2; ++k) acc[ai][bj][m][n] = __builtin_amdgcn_mfma_f32_16x16x32_bf16(Bt.v[n][k], At.v[m][k], acc[ai][bj][m][n], 0, 0, 0); } } \
        __builtin_amdgcn_s_setprio(0); } while (0)
#define PG8_WAIT_V(n) asm volatile("s_waitcnt vmcnt(" #n ")" ::: "memory")
#define PG8_WAIT_L(n) asm volatile("s_waitcnt lgkmcnt(" #n ")" ::: "memory")
#define PG8_BAR __builtin_amdgcn_s_barrier()
#define PG8_SCHED __builtin_amdgcn_sched_barrier(0)
#define PG8_VOA(dst, u) do { _Pragma("unroll") for (int _h = 0; _h < 2; ++_h) _Pragma("unroll") for (int _i = 0; _i < 2; ++_i) \
        dst[_h][_i] = AR.row(u, _h * HALF + pR[_i]) * (unsigned)KB + (unsigned)pC[_i] * 2u; } while (0)
    Unit cur, nxt; int ui = 0;
    if (!S.next(0, cur)) return;
    f32x4 acc[2][2][4][2];
#pragma unroll
    for (int a = 0; a < 2; ++a)
#pragma unroll
        for (int b = 0; b < 2; ++b)
#pragma unroll
            for (int m = 0; m < 4; ++m)
#pragma unroll
                for (int n = 0; n < 2; ++n) acc[a][b][m][n] = (f32x4){0.f, 0.f, 0.f, 0.f};
    typedef typename FragT<FP8>::A4 FragA; typedef typename FragT<FP8>::B2 FragB;
    FragA At; FragB B0, B1;
    unsigned voAc[2][2], voAn[2][2];
    if constexpr (GATHER) { PG8_VOA(voAc, cur); }
    const char* cA = GATHER ? (const char*)g.A : (const char*)g.A + (size_t)cur.pm * tstep;
    const char* cB = (const char*)g.Bt + (size_t)cur.pn * tstep;
    PG8_STAGE(PG8_SB(0, 0), cB, voffB); PG8_STAGE(PG8_SB(0, 1), cB + hstep, voffB); PG8_STAGE_A(PG8_SA(0, 0), cA, 0); PG8_STAGE_A(PG8_SA(0, 1), cA, 1);
    if (wr == 1) PG8_BAR;
    PG8_WAIT_V(2); PG8_BAR;
    PG8_STAGE(PG8_SB(1, 0), cB + kstep, voffB); PG8_STAGE_A(PG8_SA(1, 0), cA + kstep, 0); PG8_STAGE(PG8_SB(1, 1), cB + hstep + kstep, voffB);
    PG8_WAIT_V(6); PG8_BAR;
    for (;;) {
        const bool has_next = S.next(ui + 1, nxt);
        if constexpr (GATHER) {
            if (has_next && nxt.pm != cur.pm) { PG8_VOA(voAn, nxt); }
            else {
#pragma unroll
                for (int h = 0; h < 2; ++h)
#pragma unroll
                    for (int i = 0; i < 2; ++i) voAn[h][i] = voAc[h][i]; }
        }
        const char* nA = (!GATHER && has_next) ? (const char*)g.A + (size_t)nxt.pm * tstep : cA;
        const char* nB = has_next ? (const char*)g.Bt + (size_t)nxt.pn * tstep : cB;
#pragma unroll 1
        for (int t = 0; t < nt; t += 2) {
            const bool last = (t == nt - 2);
            const char* a1 = cA + (size_t)(t + 1) * kstep;
            const char* a2 = last ? nA : cA + (size_t)(t + 2) * kstep; const char* b2 = last ? nB : cB + (size_t)(t + 2) * kstep;
            const char* a3 = a2 + kstep; const char* b3 = b2 + kstep;
            PG8_LDB(B0, 0, 0); PG8_LDB(B1, 0, 1); PG8_SCHED; PG8_LDA(At, 0, 0); PG8_STAGE_A(PG8_SA(1, 1), a1, 1);
            if constexpr (GATHER) { if (last) {
#pragma unroll
                for (int h = 0; h < 2; ++h)
#pragma unroll
                    for (int i = 0; i < 2; ++i) voAc[h][i] = voAn[h][i]; } }
            PG8_WAIT_V(8); PG8_WAIT_L(0); PG8_BAR; PG8_MMA(0, 0, At, B0); PG8_MMA(0, 1, At, B1); PG8_BAR; PG8_SCHED;
            PG8_LDA(At, 0, 1); PG8_STAGE(PG8_SB(0, 0), b2, voffB); PG8_STAGE(PG8_SB(0, 1), b2 + hstep, voffB); PG8_STAGE_A(PG8_SA(0, 0), a2, 0);
            PG8_WAIT_V(8); PG8_WAIT_L(0); PG8_BAR; PG8_MMA(1, 0, At, B0); PG8_MMA(1, 1, At, B1); PG8_BAR; PG8_SCHED;
            PG8_LDB(B0, 1, 0); PG8_LDB(B1, 1, 1); PG8_SCHED; PG8_LDA(At, 1, 0); PG8_STAGE_A(PG8_SA(0, 1), a2, 1);
            PG8_WAIT_V(8); PG8_WAIT_L(0); PG8_BAR; PG8_MMA(0, 0, At, B0); PG8_MMA(0, 1, At, B1); PG8_BAR; PG8_SCHED;
            PG8_LDA(At, 1, 1); PG8_STAGE(PG8_SB(1, 0), b3, voffB); PG8_STAGE(PG8_SB(1, 1), b3 + hstep, voffB); PG8_STAGE_A(PG8_SA(1, 0), a3, 0);
            PG8_WAIT_V(8); PG8_WAIT_L(0); PG8_BAR; PG8_MMA(1, 0, At, B0); PG8_MMA(1, 1, At, B1); PG8_BAR; PG8_SCHED;
        }
        if constexpr (ALIGN_EPI) { if (wr == 0) PG8_BAR; }
        E(acc, cur, wr, wc, fr, fq);
        if (!has_next) break;
#pragma unroll
        for (int a = 0; a < 2; ++a)
#pragma unroll
            for (int b = 0; b < 2; ++b)
#pragma unroll
                for (int m = 0; m < 4; ++m)
#pragma unroll
                    for (int n = 0; n < 2; ++n) acc[a][b][m][n] = (f32x4){0.f, 0.f, 0.f, 0.f};
        cur = nxt; cA = nA; cB = nB; ++ui;
        if constexpr (ALIGN_EPI) { if (wr == 1) PG8_BAR; }
    }
    PG8_WAIT_V(0);
    if constexpr (!ALIGN_EPI) { if (wr == 0) PG8_BAR; }
    PG8_BAR;
#undef PG8_SA
#undef PG8_SB
#undef PG8_STAGE
#undef PG8_STAGE_A
#undef PG8_LDA
#undef PG8_LDB
#undef PG8_MMA
#undef PG8_LD16
#undef PG8_WAIT_V
#undef PG8_WAIT_L
#undef PG8_BAR
#undef PG8_SCHED
#undef PG8_VOA
}
}

namespace attn2 {
using bf16 = __hip_bfloat16;
using bf16x8 = __attribute__((ext_vector_type(8))) short;
using s16x4  = __attribute__((ext_vector_type(4))) short;
using f32x16 = __attribute__((ext_vector_type(16))) float;
using u32x4  = __attribute__((ext_vector_type(4))) unsigned;
constexpr int NW = 8, QBLK = 32, KVBLK = 64, SEQ = 2048, LDP = 2816, LDO = 512;
constexpr float THRL = 11.5f;
constexpr int SHM_V = KVBLK * 128 * 2, SHM_K = KVBLK * 64 * 2;
constexpr int LDS_WS = 2 * SHM_V + 2 * SHM_K, LDS_TAB = LDS_WS + NW * 64 * 4, LDS_BYTES = LDS_TAB + 16384;
#define KSWZ64(row, colB) ((row) * 128 + ((colB) ^ ((((row) >> 1) & 7) << 4)))
#define SBAR() __builtin_amdgcn_sched_barrier(0)
typedef __attribute__((address_space(3))) const float* lds_fptr;
__device__ __forceinline__ int crow(int r, int hi) { return (r & 3) + 8 * (r >> 2) + 4 * hi; }
__device__ __forceinline__ unsigned cvtpk(float lo, float hi) { unsigned r; asm volatile("v_cvt_pk_bf16_f32 %0, %1, %2" : "=v"(r) : "v"(lo), "v"(hi)); return r; }
__device__ __forceinline__ float add_bias(f32x16& p0, f32x16& p1, int t, int qw0, int qabs, int hi, lds_fptr tab, float clo, float chi) {
  const int relmin = 64 * t - (qw0 + 31), relmax = 64 * t + 63 - qw0;
  if (relmax <= -128 || relmin >= 128) return relmin >= 128 ? chi : clo;
  const lds_fptr tp = tab + (64 * t - qabs + 256 + 4 * hi);
#pragma unroll
  for (int r = 0; r < 16; ++r) { const int o = (r & 3) + 8 * (r >> 2); p0[r] += tp[o]; p1[r] += tp[o + 32]; }
  return 0.f;
}
__device__ __forceinline__ void partialSM(f32x16& p0, f32x16& p1, float cb, float& m_reg, float& alpha) {
  float pmax = p0[0];
#pragma unroll
  for (int r = 1; r < 16; ++r) pmax = fmaxf(pmax, p0[r]);
#pragma unroll
  for (int r = 0; r < 16; ++r) pmax = fmaxf(pmax, p1[r]);
  { auto rr = __builtin_amdgcn_permlane32_swap(__float_as_uint(pmax), __float_as_uint(pmax), false, false);
    pmax = fmaxf(__uint_as_float(rr[0]), __uint_as_float(rr[1])) + cb; }
  float mn;
  if (__builtin_expect(__all(pmax - m_reg <= THRL), 1)) { mn = m_reg; alpha = 1.f; }
  else { mn = fmaxf(m_reg, pmax); alpha = __builtin_amdgcn_exp2f(m_reg - mn); m_reg = mn; }
  const float sub = mn - cb;
#pragma unroll
  for (int r = 0; r < 16; ++r) { p0[r] -= sub; p1[r] -= sub; }
#pragma unroll
  for (int r = 0; r < 16; ++r) p0[r] = __builtin_amdgcn_exp2f(p0[r]);
}
__device__ __forceinline__ void finishSM(f32x16& p0, f32x16& p1, float alpha, float& l_reg, bf16x8& pa0, bf16x8& pa1, bf16x8& pa2, bf16x8& pa3) {
#pragma unroll
  for (int r = 0; r < 16; ++r) p1[r] = __builtin_amdgcn_exp2f(p1[r]);
  float ps = 0;
#pragma unroll
  for (int r = 0; r < 16; ++r) ps += p0[r];
#pragma unroll
  for (int r = 0; r < 16; ++r) ps += p1[r];
  { auto rr = __builtin_amdgcn_permlane32_swap(__float_as_uint(ps), __float_as_uint(ps), false, false);
    ps = __uint_as_float(rr[0]) + __uint_as_float(rr[1]); }
  l_reg = l_reg * alpha + ps;
#define PK4(P, BASE, OUT) do { unsigned a0 = cvtpk(P[BASE + 0], P[BASE + 1]), a1 = cvtpk(P[BASE + 2], P[BASE + 3]);   \
    unsigned b0 = cvtpk(P[BASE + 4], P[BASE + 5]), b1 = cvtpk(P[BASE + 6], P[BASE + 7]);                              \
    auto r0 = __builtin_amdgcn_permlane32_swap(a0, b0, false, false); auto r1 = __builtin_amdgcn_permlane32_swap(a1, b1, false, false); \
    u32x4 w = {r0[0], r1[0], r0[1], r1[1]}; OUT = *reinterpret_cast<bf16x8*>(&w); } while (0)
  PK4(p0, 0, pa0); PK4(p0, 8, pa1); PK4(p1, 0, pa2); PK4(p1, 8, pa3);
#undef PK4
}
__device__ __forceinline__ void qkt(f32x16& p0, f32x16& p1, const bf16* Ks, const bf16x8* qr, int r32, int hi) {
  p0 = f32x16{}; p1 = f32x16{};
#pragma unroll
  for (int d0 = 0; d0 < 4; ++d0) { const int cb = (d0 * 16 + hi * 8) * 2;
    bf16x8 b0 = *reinterpret_cast<const bf16x8*>((const char*)Ks + KSWZ64(r32, cb));
    bf16x8 b1 = *reinterpret_cast<const bf16x8*>((const char*)Ks + KSWZ64(32 + r32, cb));
    p0 = __builtin_amdgcn_mfma_f32_32x32x16_bf16(b0, qr[d0], p0, 0, 0, 0);
    p1 = __builtin_amdgcn_mfma_f32_32x32x16_bf16(b1, qr[d0], p1, 0, 0, 0); }
}
__device__ __forceinline__ int v_st(int k, int c) { const int kk = (k & ~0xC) | ((k & 4) << 1) | ((k & 8) >> 1); return ((kk >> 3) * 4 + (c >> 5)) * 512 + ((kk & 7) * 32 + (c & 31)) * 2; }
__device__ __forceinline__ int v_rd_base(int lane) { return ((lane & 3) << 3) | (((lane >> 2) & 3) << 6) | (((lane >> 4) & 1) << 5) | (((lane >> 5) & 1) << 8); }
constexpr int v_rd_off(int d0, int ks, int half) { return d0 * 512 + ks * 4096 + half * 2048; }
template <int OFF> __device__ __forceinline__ s16x4 tr_read(int vb) {
  s16x4 r; asm volatile("ds_read_b64_tr_b16 %0, %1 offset:%2" : "=&v"(r) : "v"(vb), "i"(OFF) : "memory"); return r;
}
template <int D0> __device__ __forceinline__ void pv_one(f32x16& od, int vb, bf16x8 pa0, bf16x8 pa1, bf16x8 pa2, bf16x8 pa3) {
  const s16x4 l0 = tr_read<v_rd_off(D0, 0, 0)>(vb), h0 = tr_read<v_rd_off(D0, 0, 1)>(vb), l1 = tr_read<v_rd_off(D0, 1, 0)>(vb), h1 = tr_read<v_rd_off(D0, 1, 1)>(vb);
  const s16x4 l2 = tr_read<v_rd_off(D0, 2, 0)>(vb), h2 = tr_read<v_rd_off(D0, 2, 1)>(vb), l3 = tr_read<v_rd_off(D0, 3, 0)>(vb), h3 = tr_read<v_rd_off(D0, 3, 1)>(vb);
  asm volatile("s_waitcnt lgkmcnt(0)" ::: "memory"); SBAR();
#define PK(L, H) (bf16x8){L[0], L[1], L[2], L[3], H[0], H[1], H[2], H[3]}
  od = __builtin_amdgcn_mfma_f32_32x32x16_bf16(pa0, PK(l0, h0), od, 0, 0, 0);
  od = __builtin_amdgcn_mfma_f32_32x32x16_bf16(pa1, PK(l1, h1), od, 0, 0, 0);
  od = __builtin_amdgcn_mfma_f32_32x32x16_bf16(pa2, PK(l2, h2), od, 0, 0, 0);
  od = __builtin_amdgcn_mfma_f32_32x32x16_bf16(pa3, PK(l3, h3), od, 0, 0, 0);
#undef PK
}
__device__ __forceinline__ void pv_d0(f32x16* o, int vb, bf16x8 pa0, bf16x8 pa1, bf16x8 pa2, bf16x8 pa3) {
  pv_one<0>(o[0], vb, pa0, pa1, pa2, pa3); pv_one<1>(o[1], vb, pa0, pa1, pa2, pa3); pv_one<2>(o[2], vb, pa0, pa1, pa2, pa3); pv_one<3>(o[3], vb, pa0, pa1, pa2, pa3);
}
template <class Hook>
__device__ __forceinline__ void attn_unit(const bf16* __restrict__ Qb, const bf16* __restrict__ Kh, const bf16* __restrict__ Vh, bf16* __restrict__ Ob, int qb, char* lds, const float* tabsrc, float clo, float chi, Hook& hk) {
  const int tid = threadIdx.x, wid = __builtin_amdgcn_readfirstlane(tid >> 6), lane = tid & 63, r32 = lane & 31, hi = lane >> 5;
  bf16* V_lds = (bf16*)lds; bf16* K_lds = (bf16*)(lds + 2 * SHM_V);
  float* ws = (float*)(lds + LDS_WS) + wid * 64; float* li_l = ws; float* al_l = ws + 32;
  const lds_fptr tab = (lds_fptr)((__attribute__((address_space(3))) const char*)lds + LDS_TAB);
  float m_reg = -1e30f, l_reg = 0; f32x16 o[4] = {}; bf16x8 qr[4];
  const bf16* Qw = Qb + (long)(wid * QBLK + r32) * LDP + hi * 8;
#pragma unroll
  for (int d0 = 0; d0 < 4; ++d0) qr[d0] = *reinterpret_cast<const bf16x8*>(Qw + d0 * 16);
  const int qw0 = qb * 256 + wid * QBLK, qabs = qw0 + r32;
  const int kr = tid >> 3, kc = (tid & 7) * 8, kst = KSWZ64(kr, kc * 2);
  const int sr = tid >> 4, sc = (tid & 15) * 8, vst0 = v_st(sr, sc), vst1 = v_st(32 + sr, sc);
  const int vb0 = (int)(uintptr_t)V_lds + v_rd_base(lane);
  struct { bf16x8 vs0, vs1, ks0; } sr_[2];
  const unsigned voV = (unsigned)((sr * LDP + sc) * 2), voK = (unsigned)((kr * LDP + kc) * 2);
#define GLD16(d, vo, sb) asm volatile("global_load_dwordx4 %0, %1, %2" : "=v"(d) : "v"(vo), "s"(sb) : "memory")
#define SLOAD(i, k0) do { const bf16* vt_ = Vh + (long)(k0) * LDP; GLD16(sr_[i].vs0, voV, vt_); GLD16(sr_[i].vs1, voV, vt_ + 32 * LDP); GLD16(sr_[i].ks0, voK, Kh + (long)(k0) * LDP); } while (0)
#define FWAIT(nh) do { if ((nh) == 6) asm volatile("s_waitcnt vmcnt(9)" ::: "memory"); else if ((nh) == 4) asm volatile("s_waitcnt vmcnt(7)" ::: "memory"); \
    else if ((nh) == 2) asm volatile("s_waitcnt vmcnt(5)" ::: "memory"); else asm volatile("s_waitcnt vmcnt(3)" ::: "memory"); } while (0)
#define SWRITE(b, i) do { *(bf16x8*)((char*)V_lds + (b) * SHM_V + vst0) = sr_[i].vs0; *(bf16x8*)((char*)V_lds + (b) * SHM_V + vst1) = sr_[i].vs1; \
    *(bf16x8*)((char*)K_lds + (b) * SHM_K + kst) = sr_[i].ks0; } while (0)
#define SWAIT() asm volatile("s_waitcnt vmcnt(3)" ::: "memory")
#define ABAR() asm volatile("s_waitcnt lgkmcnt(0)\n\ts_barrier" ::: "memory")
#define RESC(a) do { if (__any((a) < 1.f)) { if (hi == 0) al_l[r32] = (a); asm volatile("s_waitcnt lgkmcnt(0)" ::: "memory"); \
    _Pragma("unroll") for (int d = 0; d < 4; ++d) _Pragma("unroll") for (int r = 0; r < 16; ++r) o[d][r] *= al_l[crow(r, hi)]; } } while (0)
  f32x16 pA0, pA1, pB0, pB1; float alA, alB; bf16x8 pa0, pa1, pa2, pa3; constexpr int NT = SEQ / KVBLK;
  constexpr int SE = 0, SO = 1;
  SLOAD(SE, 0); SLOAD(SO, KVBLK);
  if (tabsrc) ((float*)(lds + LDS_TAB))[tid] = tabsrc[tid];
  asm volatile("s_waitcnt vmcnt(0)" ::: "memory"); SWRITE(0, SE); SWRITE(1, SO); ABAR();
  SLOAD(SE, 2 * KVBLK);
  asm volatile("" ::: "memory"); int nh = hk.stepB();
  qkt(pA0, pA1, K_lds, qr, r32, hi); { const float cb = add_bias(pA0, pA1, 0, qw0, qabs, hi, tab, clo, chi); partialSM(pA0, pA1, cb, m_reg, alA); }
  for (int j = 1; j + 1 < NT; j += 2) {
    SBAR(); qkt(pB0, pB1, (bf16*)((char*)K_lds + SHM_K), qr, r32, hi);
    finishSM(pA0, pA1, alA, l_reg, pa0, pa1, pa2, pa3); SBAR();
    SLOAD(SO, (j + 2) * KVBLK); SBAR();
    pv_d0(o, vb0, pa0, pa1, pa2, pa3); { const float cb = add_bias(pB0, pB1, j, qw0, qabs, hi, tab, clo, chi); partialSM(pB0, pB1, cb, m_reg, alB); }
    ABAR(); FWAIT(nh); SWRITE(0, SE);
    asm volatile("" ::: "memory"); hk.issue_half(1);
    RESC(alB); ABAR();
    SBAR(); qkt(pA0, pA1, K_lds, qr, r32, hi);
    finishSM(pB0, pB1, alB, l_reg, pa0, pa1, pa2, pa3); SBAR();
    SLOAD(SE, (j + 3 < NT ? j + 3 : NT - 1) * KVBLK); SBAR();
    pv_d0(o, vb0 + (int)SHM_V, pa0, pa1, pa2, pa3); { const float cb = add_bias(pA0, pA1, j + 1, qw0, qabs, hi, tab, clo, chi); partialSM(pA0, pA1, cb, m_reg, alA); }
    ABAR(); SWAIT(); SWRITE(1, SO);
    asm volatile("" ::: "memory"); nh = hk.stepB();
    RESC(alA); ABAR();
  }
  asm volatile("" ::: "memory"); hk.issue_half(1);
  SBAR(); qkt(pB0, pB1, (bf16*)((char*)K_lds + SHM_K), qr, r32, hi);
  finishSM(pA0, pA1, alA, l_reg, pa0, pa1, pa2, pa3); SBAR();
  pv_d0(o, vb0, pa0, pa1, pa2, pa3); { const float cb = add_bias(pB0, pB1, NT - 1, qw0, qabs, hi, tab, clo, chi); partialSM(pB0, pB1, cb, m_reg, alB); }
  ABAR(); RESC(alB);
  finishSM(pB0, pB1, alB, l_reg, pa0, pa1, pa2, pa3); SBAR();
  pv_d0(o, vb0 + (int)SHM_V, pa0, pa1, pa2, pa3);
  if (hi == 0) li_l[r32] = l_reg; asm volatile("s_waitcnt lgkmcnt(0)" ::: "memory");
  float rli[16];
#pragma unroll
  for (int r = 0; r < 16; ++r) rli[r] = __builtin_amdgcn_rcpf(li_l[crow(r, hi)]);
  bf16* Ow = Ob + (long)(wid * QBLK) * LDO;
#pragma unroll
  for (int r = 0; r < 16; ++r) { const int orow = crow(r, hi);
#pragma unroll
    for (int d0 = 0; d0 < 4; ++d0) Ow[(long)orow * LDO + d0 * 32 + r32] = __float2bfloat16(o[d0][r] * rli[r]); }
  ABAR();
#undef SLOAD
#undef GLD16
#undef FWAIT
#undef SWRITE
#undef SWAIT
#undef RESC
#undef ABAR
}
#undef SBAR
#undef KSWZ64
}

constexpr int NWAVES = 8;
constexpr int N_LAUNCHES = MK_N_LAUNCHES;
constexpr int PER_PHASE = 11;
constexpr int NB = 8, SEQL = 2048, DMODEL = 1024, MTOK = NB * SEQL;
constexpr int NPC = 2816, NINC = 2832;
constexpr int QOFF = 0, KOFF = 512, VOFF = 1024, ZOFF = 1536, XBCOFF = 2048;
constexpr int NE = 16, CAP = 256, FFD = 2816;
constexpr int NCH = 16, CHK = 128;
constexpr float EPSN = 1e-6f;
constexpr float LOG2E = 1.4426950408889634f;

constexpr size_t MiB = 1u << 20;
constexpr size_t WS_CTL = 0, CTL_ZERO_BYTES = 64 * 1024;
constexpr size_t WS_MOD = 1 * MiB;
constexpr size_t WS_TAB = 1 * MiB + 256 * 1024;
constexpr size_t WS_LAM = 1 * MiB + 512 * 1024;
constexpr size_t WS_DUMMY = 1 * MiB + 768 * 1024;
constexpr size_t WS_TOT = 1 * MiB + 576 * 1024;
constexpr size_t WS_WIN = 2 * MiB, WS_WOUT = 8 * MiB, WS_WGU = 10 * MiB, WS_WD = 186 * MiB;
constexpr size_t WS_H2 = 274 * MiB;
constexpr size_t WS_SIN = 290 * MiB;
constexpr size_t WS_Y = 306 * MiB;
constexpr size_t WS_ST = 306 * MiB;
constexpr size_t WS_AORAW = 338 * MiB;
constexpr size_t WS_HID = 370 * MiB;
constexpr size_t WS_P = 370 * MiB;
constexpr size_t WS_XN = 458 * MiB;
constexpr size_t WS_X1 = 458 * MiB;
constexpr size_t WS_AO = 490 * MiB;
constexpr size_t WS_XA = 522 * MiB;
constexpr size_t WS_DTRAW = 546 * MiB, WS_DTV = 547 * MiB, WS_CS = 548 * MiB, WS_AFF = 549 * MiB;
constexpr size_t WS_IDX = 550 * MiB, WS_GATE = 550 * MiB + 512 * 1024, WS_SLOT = 551 * MiB, WS_END = 552 * MiB;
constexpr int CW_BAR = 4096;

constexpr int RING_OFF = 0, RING_BYTES = 131072;
constexpr int LDSCTL_OFF = 146432, MISC_OFF = LDSCTL_OFF + 320;
constexpr int LDS_BYTES = 147456;

#define GAS __attribute__((address_space(1)))
#define LAS __attribute__((address_space(3)))
typedef unsigned short bf16;
typedef unsigned v4u __attribute__((ext_vector_type(4)));
typedef unsigned v2u __attribute__((ext_vector_type(2)));
typedef float f32x4 __attribute__((ext_vector_type(4)));
typedef short bf16x8 __attribute__((ext_vector_type(8)));
typedef unsigned short u16x8 __attribute__((ext_vector_type(8)));
typedef GAS unsigned gu32;
#define RLX_AGENT __ATOMIC_RELAXED, __HIP_MEMORY_SCOPE_AGENT
#define LDS_WAIT() asm volatile("s_waitcnt lgkmcnt(0)" ::: "memory")
#define VM_WAIT() asm volatile("s_waitcnt vmcnt(0)" ::: "memory")
__device__ __forceinline__ unsigned f2bf(float f) { unsigned u = __builtin_bit_cast(unsigned, f); return (u + 0x7fffu + ((u >> 16) & 1u)) >> 16; }
__device__ __forceinline__ unsigned pk2(float lo, float hi) { return f2bf(lo) | (f2bf(hi) << 16); }
__device__ __forceinline__ float bf2f(unsigned short h) { return __builtin_bit_cast(float, (unsigned)h << 16); }
__device__ __forceinline__ float silu(float v) { return v / (1.f + __expf(-v)); }

#define XB_TMO      128
#define XB_XCNT(j)  (256  + 64 * (j))
#define XB_XSUB(j)  (1280 + 64 * (j))
#define XB_XGEN(j)  (2304 + 64 * (j))
#define XB_TOP      3328
#define XB_TOPGEN   3392
#define XCD_BAR_WORDS 3456
#define XB_SPIN_CAP (1u << 18)

__device__ __forceinline__ unsigned xb_ld(unsigned* p)              { return __hip_atomic_load(p, __ATOMIC_RELAXED, __HIP_MEMORY_SCOPE_AGENT); }
__device__ __forceinline__ unsigned xb_add(unsigned* p, unsigned v) { return __hip_atomic_fetch_add(p, v, __ATOMIC_RELAXED, __HIP_MEMORY_SCOPE_AGENT); }
__device__ __forceinline__ unsigned xb_xcc_id() { return (unsigned)__builtin_amdgcn_s_getreg((3 << 11) | 20) & 0xFu; }
#define XB_SPIN(cond, bar) do { unsigned _sp = 0; while (cond) { __builtin_amdgcn_s_sleep(1); \
    if ((++_sp & 255u) == 0u) { if (xb_ld(&(bar)[XB_TMO])) break; if (_sp > XB_SPIN_CAP) { atomicAdd(&(bar)[XB_TMO], 1u); break; } } } } while (0)

struct XcdBarrier {
    unsigned* bar; unsigned x;
    volatile LAS unsigned* st;
};

__device__ __forceinline__ XcdBarrier xcd_barrier_post(unsigned* bar, volatile LAS unsigned* st) {
    XcdBarrier b; b.bar = bar; b.x = xb_xcc_id(); b.st = st;
    if (threadIdx.x == 0) (void)xb_add(&bar[XB_XCNT(b.x)], 1u);
    return b;
}
__device__ __forceinline__ void xcd_barrier_complete(unsigned* bar, unsigned x, unsigned& nloc, unsigned& nx) {
    const unsigned G = gridDim.x * gridDim.y * gridDim.z;
    unsigned sum, cnt, mine, sp = 0u;
    for (;;) {
        sum = 0u; cnt = 0u; mine = 0u;
#pragma unroll
        for (unsigned j = 0; j < 16; ++j) { const unsigned c = xb_ld(&bar[XB_XCNT(j)]); sum += c; cnt += (c > 0u) ? 1u : 0u; mine = (j == x) ? c : mine; }
        if (sum == G) break;
        __builtin_amdgcn_s_sleep(1);
        if ((++sp & 255u) == 0u) { if (xb_ld(&bar[XB_TMO])) break; if (sp > XB_SPIN_CAP) { atomicAdd(&bar[XB_TMO], 1u); break; } }
    }
    nloc = mine > 0u ? mine : 1u; nx = cnt > 0u ? cnt : 1u;
}

__device__ __forceinline__ void xcd_barrier(const XcdBarrier& b) {
    asm volatile("s_waitcnt vmcnt(0)" ::: "memory");
    __syncthreads();
    if (threadIdx.x == 0) {
        unsigned* bar = b.bar;
        __builtin_amdgcn_s_waitcnt(0);
        unsigned nloc = b.st[0], nx = b.st[1];
        if (nloc == 0u) { xcd_barrier_complete(bar, b.x, nloc, nx); b.st[0] = nloc; b.st[1] = nx; }
        const unsigned old = xb_add(&bar[XB_XSUB(b.x)], 1u);
        const unsigned gen = old / nloc;
        if (old + 1u == (gen + 1u) * nloc) {
            __builtin_amdgcn_fence(__ATOMIC_RELEASE, "agent");
            asm volatile("s_waitcnt vmcnt(0)" ::: "memory");
            const unsigned og = xb_add(&bar[XB_TOP], 1u);
            const unsigned tg = og / nx;
            if (og + 1u == (tg + 1u) * nx) xb_add(&bar[XB_TOPGEN], 1u);
            else XB_SPIN(xb_ld(&bar[XB_TOPGEN]) == tg, bar);
            __builtin_amdgcn_fence(__ATOMIC_ACQUIRE, "agent");
            xb_add(&bar[XB_XGEN(b.x)], 1u);
            asm volatile("s_waitcnt vmcnt(0)" ::: "memory");
        } else {
            XB_SPIN(xb_ld(&bar[XB_XGEN(b.x)]) == gen, bar);
            __builtin_amdgcn_fence(__ATOMIC_ACQUIRE, "agent");
            asm volatile("s_waitcnt vmcnt(0)" ::: "memory");
        }
    }
    __syncthreads();
}


__device__ __forceinline__ void xcd_arrive(const XcdBarrier& b) {
    asm volatile("s_waitcnt vmcnt(0)" ::: "memory");
    __syncthreads();
    if (threadIdx.x == 0) {
        unsigned* bar = b.bar;
        __builtin_amdgcn_s_waitcnt(0);
        unsigned nloc = b.st[0], nx = b.st[1];
        if (nloc == 0u) { xcd_barrier_complete(bar, b.x, nloc, nx); b.st[0] = nloc; b.st[1] = nx; }
        const unsigned old = xb_add(&bar[XB_XSUB(b.x)], 1u);
        const unsigned gen = old / nloc;
        if (old + 1u == (gen + 1u) * nloc) {
            __builtin_amdgcn_fence(__ATOMIC_RELEASE, "agent");
            asm volatile("s_waitcnt vmcnt(0)" ::: "memory");
            const unsigned og = xb_add(&bar[XB_TOP], 1u);
            const unsigned tg = og / nx;
            if (og + 1u == (tg + 1u) * nx) xb_add(&bar[XB_TOPGEN], 1u);
            else XB_SPIN(xb_ld(&bar[XB_TOPGEN]) == tg, bar);
            __builtin_amdgcn_fence(__ATOMIC_ACQUIRE, "agent");
            xb_add(&bar[XB_XGEN(b.x)], 1u);
            asm volatile("s_waitcnt vmcnt(0)" ::: "memory");
            b.st[4] = 1u;
        } else { b.st[4] = 0u; b.st[5] = gen; }
    }
}
__device__ __forceinline__ void xcd_wait(const XcdBarrier& b) {
    if (threadIdx.x == 0) {
        if (b.st[4] == 0u) { unsigned* bar = b.bar; const unsigned gen = b.st[5];
            XB_SPIN(xb_ld(&bar[XB_XGEN(b.x)]) == gen, bar);
            __builtin_amdgcn_fence(__ATOMIC_ACQUIRE, "agent");
            asm volatile("s_waitcnt vmcnt(0)" ::: "memory"); }
    }
    __syncthreads();
}

struct Frame {
    LAS unsigned char* lds;
    volatile LAS unsigned* MISC;
    gu32* ctl;
    int tid, lane, wave;
    int vcu, G;
    const float* in[27]; float* out; unsigned char* ws;
};
enum { I_X = 0, I_C, I_ADAW, I_ADAB, I_GMIX, I_GFFN, I_GFIN, I_WIN, I_LQ1, I_LK1, I_LQ2, I_LK2, I_SUBLN, I_RELT, I_CONVW, I_CONVB, I_DTBF, I_DTBB, I_ALOGF, I_ALOGB, I_DSKIP, I_SSMG, I_WOUT, I_ROUTW, I_WGATE, I_WUP, I_WDOWN };

__device__ __forceinline__ float wave_sum(float v) {
#pragma unroll
    for (int o = 1; o < 64; o <<= 1) v += __shfl_xor(v, o);
    return v;
}
__device__ __forceinline__ float reduce16(const float (&p)[16], int lane) {
    float q8[8], q4[4], q2[2], q1;
    const bool u5 = (lane & 32) != 0, u4 = (lane & 16) != 0, u3 = (lane & 8) != 0, u2 = (lane & 4) != 0;
#pragma unroll
    for (int i = 0; i < 8; ++i) { const float send = u5 ? p[i] : p[i + 8], keep = u5 ? p[i + 8] : p[i]; q8[i] = keep + __shfl_xor(send, 32); }
#pragma unroll
    for (int i = 0; i < 4; ++i) { const float send = u4 ? q8[i] : q8[i + 4], keep = u4 ? q8[i + 4] : q8[i]; q4[i] = keep + __shfl_xor(send, 16); }
#pragma unroll
    for (int i = 0; i < 2; ++i) { const float send = u3 ? q4[i] : q4[i + 2], keep = u3 ? q4[i + 2] : q4[i]; q2[i] = keep + __shfl_xor(send, 8); }
    { const float send = u2 ? q2[0] : q2[1], keep = u2 ? q2[1] : q2[0]; q1 = keep + __shfl_xor(send, 4); }
    q1 += __shfl_xor(q1, 2); q1 += __shfl_xor(q1, 1);
    return q1;
}
__device__ __forceinline__ int reduce16_index(int lane) { return ((lane >> 5) & 1) * 8 + ((lane >> 4) & 1) * 4 + ((lane >> 3) & 1) * 2 + ((lane >> 2) & 1); }

constexpr int P0_ITEMS_DENSE = 16 * 89 + 16 * 32, P0_ITEMS_ALL = P0_ITEMS_DENSE + 3 * 16 * 1408;
struct P0Item { const float* src; unsigned char* dst; int ldw, pitch, fp8, nv; };
__device__ __forceinline__ void p0_load(const P0Item& d, float (&v)[32], int lane) {
    const int cl = (lane & 31) < d.nv ? (lane & 31) : (lane & 15);
#pragma unroll
    for (int i = 0; i < 32; ++i) { const int kk = 2 * i + (lane >> 5); v[i] = __builtin_nontemporal_load(d.src + (size_t)kk * d.ldw + cl); }
}
__device__ __forceinline__ void p0_store(const P0Item& d, const float (&v)[32], LAS float* scr, int lane) {
#pragma unroll
    for (int i = 0; i < 32; ++i) { const int kk = 2 * i + (lane >> 5); scr[kk * 33 + (lane & 31)] = v[i]; }
    LDS_WAIT(); asm volatile("" ::: "memory");
    if (d.fp8) {
#pragma unroll
        for (int j = 0; j < 2; ++j) { const int id = lane + 64 * j, n = id >> 2, kc = id & 3; const LAS float* s = scr + (16 * kc) * 33 + n;
            v4u o;
            o.x = pg8::pk_fp8x4(s[0 * 33] * pg8::WSCALE, s[1 * 33] * pg8::WSCALE, s[2 * 33] * pg8::WSCALE, s[3 * 33] * pg8::WSCALE);
            o.y = pg8::pk_fp8x4(s[4 * 33] * pg8::WSCALE, s[5 * 33] * pg8::WSCALE, s[6 * 33] * pg8::WSCALE, s[7 * 33] * pg8::WSCALE);
            o.z = pg8::pk_fp8x4(s[8 * 33] * pg8::WSCALE, s[9 * 33] * pg8::WSCALE, s[10 * 33] * pg8::WSCALE, s[11 * 33] * pg8::WSCALE);
            o.w = pg8::pk_fp8x4(s[12 * 33] * pg8::WSCALE, s[13 * 33] * pg8::WSCALE, s[14 * 33] * pg8::WSCALE, s[15 * 33] * pg8::WSCALE);
            __builtin_nontemporal_store(o, (GAS v4u*)(d.dst + (size_t)n * d.pitch + 16 * kc)); }
    } else {
        const int c = lane & 7;
#pragma unroll
        for (int j = 0; j < 4; ++j) { const int n = (lane >> 3) + 8 * j; const LAS float* s = scr + (8 * c) * 33 + n;
            v4u o; o.x = pk2(s[0 * 33], s[1 * 33]); o.y = pk2(s[2 * 33], s[3 * 33]); o.z = pk2(s[4 * 33], s[5 * 33]); o.w = pk2(s[6 * 33], s[7 * 33]);
            __builtin_nontemporal_store(o, (GAS v4u*)(d.dst + (size_t)n * d.pitch + 16 * c)); }
    }
    LDS_WAIT(); asm volatile("" ::: "memory");
}
__device__ __forceinline__ P0Item p0_decode(Frame& F, int it) {
    constexpr int I_IN = 16 * 89, I_OUT = 16 * 32, I_EXP = 1408, I_G = 16 * I_EXP;
    P0Item d; int r = it; d.nv = 32;
    if (r < I_IN) { const int kb = r / 89, nb = r % 89; d.nv = nb == 88 ? 16 : 32; d.src = F.in[I_WIN] + (size_t)(kb * 64) * NINC + nb * 32; d.ldw = NINC; d.pitch = 2048; d.fp8 = 0; d.dst = F.ws + WS_WIN + (size_t)(nb * 32) * 2048 + kb * 128; return d; } r -= I_IN;
    if (r < I_OUT) { const int kb = r / 32, nb = r % 32; d.src = F.in[I_WOUT] + (size_t)(kb * 64) * 1024 + nb * 32; d.ldw = 1024; d.pitch = 2048; d.fp8 = 0; d.dst = F.ws + WS_WOUT + (size_t)(nb * 32) * 2048 + kb * 128; return d; } r -= I_OUT;
    if (r < 2 * I_G) { const int up = r >= I_G; if (up) r -= I_G; const int e = r / I_EXP, rr = r % I_EXP, kb = rr / 88, nb = rr % 88, n0 = nb * 32;
        d.src = (up ? F.in[I_WUP] : F.in[I_WGATE]) + (size_t)e * 1024 * FFD + (size_t)(kb * 64) * FFD + n0; d.ldw = FFD; d.pitch = 1024; d.fp8 = 1;
        d.dst = F.ws + WS_WGU + (size_t)(e * 5632 + 256 * (n0 >> 7) + (n0 & 127) + (up ? 128 : 0)) * 1024 + kb * 64; return d; } r -= 2 * I_G;
    { const int e = r / I_EXP, rr = r % I_EXP, kb = rr / 32, nb = rr % 32;
        d.src = F.in[I_WDOWN] + (size_t)e * FFD * 1024 + (size_t)(kb * 64) * 1024 + nb * 32; d.ldw = 1024; d.pitch = FFD; d.fp8 = 1;
        d.dst = F.ws + WS_WD + (size_t)(e * 1024 + nb * 32) * FFD + kb * 64; return d; }
}

constexpr int BG_TILE_OFF = 69632, BG_TAB_OFF = BG_TILE_OFF + NWAVES * 8192, BG_MAXIT = 40;
static_assert(BG_TAB_OFF + NWAVES * BG_MAXIT * 32 <= LDSCTL_OFF, "bg table");
struct BgConv {
    Frame* F; unsigned ldsb; LAS float* tile; LAS unsigned* tab; int k, nit, inflight; unsigned char* dst; int pitch;
    __device__ __forceinline__ void init(Frame& Fr) { F = &Fr; tile = (LAS float*)(Fr.lds + RING_OFF + BG_TILE_OFF + Fr.wave * 8192); ldsb = (unsigned)(uintptr_t)tile;
        tab = (LAS unsigned*)(Fr.lds + RING_OFF + BG_TAB_OFF + Fr.wave * (BG_MAXIT * 32));
        const int first = P0_ITEMS_DENSE + Fr.vcu * NWAVES + Fr.wave, stride = Fr.G * NWAVES;
        nit = first < P0_ITEMS_ALL ? (P0_ITEMS_ALL - 1 - first) / stride + 1 : 0; if (nit > BG_MAXIT) nit = BG_MAXIT;
        if (Fr.lane < nit) { const P0Item d = p0_decode(Fr, first + Fr.lane * stride); LAS unsigned* e = tab + Fr.lane * 8;
            const unsigned long long sp = (unsigned long long)(uintptr_t)d.src, dp = (unsigned long long)(uintptr_t)d.dst;
            e[0] = (unsigned)sp; e[1] = (unsigned)(sp >> 32); e[2] = (unsigned)dp; e[3] = (unsigned)(dp >> 32); e[4] = (unsigned)d.ldw * 4u; e[5] = (unsigned)d.pitch; }
        LDS_WAIT(); asm volatile("" ::: "memory");
        k = 0; inflight = 0; dst = nullptr; pitch = 0; }
    __device__ __forceinline__ int issue_half(int half) {
        if (k >= nit) return 0;
        const LAS unsigned* e = tab + k * 8;
        const v4u e0 = *(const LAS v4u*)e; const v2u e1 = *(const LAS v2u*)(e + 4);
        const unsigned s0 = __builtin_amdgcn_readfirstlane(e0.x), s1 = __builtin_amdgcn_readfirstlane(e0.y), d0 = __builtin_amdgcn_readfirstlane(e0.z), d1 = __builtin_amdgcn_readfirstlane(e0.w);
        const unsigned ldwb = __builtin_amdgcn_readfirstlane(e1.x), pt = __builtin_amdgcn_readfirstlane(e1.y);
        unsigned long long sb = (((unsigned long long)s1 << 32) | s0) + (unsigned long long)ldwb * (half ? 32ull : 0ull);
        const unsigned rowoff = (unsigned)(F->lane >> 3) * ldwb, l16 = (unsigned)(F->lane & 7) * 16u;
        const unsigned lb = ldsb + (half ? 4096u : 0u), sw = half ? 64u : 0u;
#pragma unroll
        for (int i = 0; i < 4; ++i) { unsigned keep; const unsigned ld = (unsigned)__builtin_amdgcn_readfirstlane((int)(lb + i * 1024));
            const unsigned vo = rowoff + ((l16 - 32u * (i >> 1) - sw) & 112u);
            asm volatile("s_mov_b32 %0, m0\n\ts_mov_b32 m0, %3\n\ts_nop 0\n\tglobal_load_lds_dwordx4 %1, %2 nt\n\ts_mov_b32 m0, %0" : "=&s"(keep) : "v"(vo), "s"(sb), "s"(ld) : "memory");
            sb += (unsigned long long)ldwb * 8ull; }
        if (half) { dst = (unsigned char*)(uintptr_t)(((unsigned long long)d1 << 32) | d0); pitch = (int)pt; inflight = 1; ++k; }
        return 4;
    }
    __device__ __forceinline__ int issue() {
        if (k >= nit) return 0;
        const LAS unsigned* e = tab + k * 8;
        const v4u e0 = *(const LAS v4u*)e; const v2u e1 = *(const LAS v2u*)(e + 4);
        const unsigned s0 = __builtin_amdgcn_readfirstlane(e0.x), s1 = __builtin_amdgcn_readfirstlane(e0.y), d0 = __builtin_amdgcn_readfirstlane(e0.z), d1 = __builtin_amdgcn_readfirstlane(e0.w);
        const unsigned ldwb = __builtin_amdgcn_readfirstlane(e1.x), pt = __builtin_amdgcn_readfirstlane(e1.y);
        unsigned long long sb = ((unsigned long long)s1 << 32) | s0;
        const unsigned rowoff = (unsigned)(F->lane >> 3) * ldwb, l16 = (unsigned)(F->lane & 7) * 16u;
#pragma unroll
        for (int i = 0; i < 8; ++i) { unsigned keep; const unsigned ld = (unsigned)__builtin_amdgcn_readfirstlane((int)(ldsb + i * 1024));
            const unsigned vo = rowoff + ((l16 - 32u * (i >> 1)) & 112u);
            asm volatile("s_mov_b32 %0, m0\n\ts_mov_b32 m0, %3\n\ts_nop 0\n\tglobal_load_lds_dwordx4 %1, %2 nt\n\ts_mov_b32 m0, %0" : "=&s"(keep) : "v"(vo), "s"(sb), "s"(ld) : "memory");
            sb += (unsigned long long)ldwb * 8ull; }
        dst = (unsigned char*)(uintptr_t)(((unsigned long long)d1 << 32) | d0); pitch = (int)pt; inflight = 1; ++k; return 8;
    }
    __device__ __forceinline__ int process() {
        if (!inflight) return 0;
        const int lane = F->lane;
#pragma unroll
        for (int j = 0; j < 2; ++j) { const int id = lane + 64 * j, n = id >> 2, kc = id & 3; const LAS float* sp = tile + (16 * kc) * 32 + ((n + 8 * kc) & 31);
            v4u o;
            o.x = pg8::pk_fp8x4(sp[0 * 32] * pg8::WSCALE, sp[1 * 32] * pg8::WSCALE, sp[2 * 32] * pg8::WSCALE, sp[3 * 32] * pg8::WSCALE);
            o.y = pg8::pk_fp8x4(sp[4 * 32] * pg8::WSCALE, sp[5 * 32] * pg8::WSCALE, sp[6 * 32] * pg8::WSCALE, sp[7 * 32] * pg8::WSCALE);
            o.z = pg8::pk_fp8x4(sp[8 * 32] * pg8::WSCALE, sp[9 * 32] * pg8::WSCALE, sp[10 * 32] * pg8::WSCALE, sp[11 * 32] * pg8::WSCALE);
            o.w = pg8::pk_fp8x4(sp[12 * 32] * pg8::WSCALE, sp[13 * 32] * pg8::WSCALE, sp[14 * 32] * pg8::WSCALE, sp[15 * 32] * pg8::WSCALE);
            __builtin_nontemporal_store(o, (GAS v4u*)(dst + (size_t)n * pitch + 16 * kc)); asm volatile("" ::: "memory"); }
        LDS_WAIT(); asm volatile("" ::: "memory");
        inflight = 0; return 2;
    }
    __device__ __forceinline__ int step() { const int a = process(); return a + issue(); }
    __device__ __forceinline__ int stepB() { const int a = process(); return a + issue_half(0); }
    __device__ __forceinline__ void drain() { VM_WAIT(); process(); while (k < nit) { issue(); VM_WAIT(); process(); } }
};

__device__ __forceinline__ void p0_prologue(Frame& F) {
    const float* c_in = F.in[I_C]; const float* ada_w = F.in[I_ADAW]; const float* ada_b = F.in[I_ADAB];
    float* MOD = (float*)(F.ws + WS_MOD);
    {
        LAS float* sc = (LAS float*)F.lds; LAS float* red = sc + 8192;
        for (int i = F.tid; i < 8192; i += 512) sc[i] = silu(c_in[i]);
        __syncthreads();
        for (int cg = F.vcu; cg < 192; cg += F.G) {
            const int col = cg * 32 + (F.lane & 31), kp = F.lane >> 5;
            float a[8];
#pragma unroll
            for (int b = 0; b < 8; ++b) a[b] = 0.f;
#pragma unroll 4
            for (int i = 0; i < 64; ++i) { const int k = F.wave * 128 + 2 * i + kp; const float w = __builtin_nontemporal_load(ada_w + (size_t)k * 6144 + col);
#pragma unroll
                for (int b = 0; b < 8; ++b) a[b] += sc[b * 1024 + k] * w; }
#pragma unroll
            for (int b = 0; b < 8; ++b) a[b] += __shfl_xor(a[b], 32);
            if (F.lane < 32) {
#pragma unroll
                for (int b = 0; b < 8; ++b) red[(F.wave * 8 + b) * 32 + F.lane] = a[b]; }
            __syncthreads();
            if (F.tid < 256) { const int b = F.tid >> 5, cl = F.tid & 31; float s = ada_b[cg * 32 + cl];
#pragma unroll
                for (int w = 0; w < 8; ++w) s += red[(w * 8 + b) * 32 + cl];
                MOD[b * 6144 + cg * 32 + cl] = s; }
            __syncthreads();
        }
    }
    {
        float* TAB = (float*)(F.ws + WS_TAB); const float* relt = F.in[I_RELT];
        for (int idx = F.vcu * 512 + F.tid; idx < 4 * 4096; idx += F.G * 512) {
            const int h = idx >> 12, i = idx & 4095; float v = 0.f;
            if (i < 4095) { const int rel = i - 2047, n = rel < 0 ? -rel : rel, ret = rel > 0 ? 16 : 0; int bk;
                if (n < 8) bk = ret + n;
                else { int large = 8 + (int)(logf((float)n / 8.0f) / 2.772588722239781f * 8.0f); large = large < 15 ? large : 15; bk = ret + large; }
                v = relt[bk * 4 + h] * LOG2E; }
            TAB[idx] = v;
        }
        if (blockIdx.x == 0 && F.wave == 0) {
            const float s1 = wave_sum(F.in[I_LQ1][F.lane] * F.in[I_LK1][F.lane]), s2 = wave_sum(F.in[I_LQ2][F.lane] * F.in[I_LK2][F.lane]);
            if (F.lane == 0) ((float*)(F.ws + WS_LAM))[0] = expf(s1) - expf(s2) + 0.2f;
        }
    }
    __syncthreads();
    {
        LAS float* scr = (LAS float*)(F.lds + RING_OFF + F.wave * 16384);
        const int gw = F.vcu * NWAVES + F.wave, NGW = F.G * NWAVES;
        constexpr int NITEMS = P0_ITEMS_DENSE;
        if (gw < NITEMS) {
            P0Item d0 = p0_decode(F, gw), d1 = d0; float a[32], bq[32], cq[32];
            p0_load(d0, a, F.lane);
            if (gw + NGW < NITEMS) { d1 = p0_decode(F, gw + NGW); p0_load(d1, bq, F.lane); }
            for (int it = gw; it < NITEMS; it += NGW) {
                const int it2 = it + 2 * NGW; P0Item d2 = d1;
                if (it2 < NITEMS) { d2 = p0_decode(F, it2); p0_load(d2, cq, F.lane); }
                p0_store(d0, a, scr, F.lane);
                if (it + NGW >= NITEMS) break;
                d0 = d1; d1 = d2;
#pragma unroll
                for (int i = 0; i < 32; ++i) { a[i] = bq[i]; bq[i] = cq[i]; }
            }
        }
        for (int it = P0_ITEMS_DENSE + gw + BG_MAXIT * NGW; it < P0_ITEMS_ALL; it += NGW) { const P0Item d = p0_decode(F, it); float a[32]; p0_load(d, a, F.lane); p0_store(d, a, scr, F.lane); }
    }
}

__device__ __forceinline__ void p1_rows(Frame& F) {
    const float* x = F.in[I_X]; const float* gm = F.in[I_GMIX]; const float* MOD = (const float*)(F.ws + WS_MOD);
    bf16* XN = (bf16*)(F.ws + WS_XN);
    const int gw = F.vcu * NWAVES + F.wave, NGW = F.G * NWAVES;
    constexpr int R = 4;
    for (int m0 = gw * R; m0 < MTOK; m0 += NGW * R) {
        const int b = m0 >> 11;
        f32x4 v[R][4]; float ss[R];
#pragma unroll
        for (int r = 0; r < R; ++r) { const GAS f32x4* xr = (const GAS f32x4*)(x + (size_t)(m0 + r) * 1024) + F.lane;
#pragma unroll
            for (int j = 0; j < 4; ++j) v[r][j] = __builtin_nontemporal_load(xr + 64 * j); }
#pragma unroll
        for (int r = 0; r < R; ++r) { float t = 0.f;
#pragma unroll
            for (int j = 0; j < 4; ++j) t += (v[r][j].x * v[r][j].x + v[r][j].y * v[r][j].y) + (v[r][j].z * v[r][j].z + v[r][j].w * v[r][j].w);
            ss[r] = t; }
#pragma unroll
        for (int o = 1; o < 64; o <<= 1) {
#pragma unroll
            for (int r = 0; r < R; ++r) ss[r] += __shfl_xor(ss[r], o); }
#pragma unroll
        for (int r = 0; r < R; ++r) ss[r] = 1.0f / sqrtf(ss[r] * (1.f / 1024.f) + EPSN);
#pragma unroll
        for (int j = 0; j < 4; ++j) { const int col = 256 * j + 4 * F.lane;
            const f32x4 g = *(const f32x4*)(gm + col), sh = *(const f32x4*)(MOD + b * 6144 + col), sc = *(const f32x4*)(MOD + b * 6144 + 1024 + col);
#pragma unroll
            for (int r = 0; r < R; ++r) { const f32x4 h = (v[r][j] * ss[r] * g) * (sc + 1.0f) + sh;
                v2u o; o.x = pk2(h.x, h.y); o.y = pk2(h.z, h.w); ((GAS v2u*)(XN + (size_t)(m0 + r) * 1024) + F.lane)[64 * j] = o; } }
    }
}

#define MFMA16(a, b, c) __builtin_amdgcn_mfma_f32_16x16x32_bf16((a), (b), (c), 0, 0, 0)
constexpr int XTP = 136;
constexpr int SLP = 72;

__device__ __forceinline__ void ssd_a_unit(Frame& F, int b, int c, int g) {
    LAS bf16* XT = (LAS bf16*)F.lds;
    LAS bf16* BT = XT + 256 * XTP;
    LAS float* WF = (LAS float*)(BT + 64 * XTP);
    const bf16* P = (const bf16*)(F.ws + WS_P); bf16* XA = (bf16*)(F.ws + WS_XA);
    const float* convw = F.in[I_CONVW]; const float* convb = F.in[I_CONVB];
    const int row0 = b * SEQL + c * CHK, s0 = c * CHK;
    if (F.tid < 384) {
        const int cv = F.tid % 48, tg = F.tid / 48;
        const int ch = cv < 32 ? g * 256 + cv * 8 : (cv < 40 ? 512 + g * 64 + (cv - 32) * 8 : 640 + g * 64 + (cv - 40) * 8);
        float w[5][8], bb[8];
#pragma unroll
        for (int i = 0; i < 8; ++i) { bb[i] = convb[ch + i];
#pragma unroll
            for (int j = 0; j < 5; ++j) w[j][i] = convw[j * 768 + ch + i]; }
        LAS bf16* TT = cv < 32 ? XT + (cv * 8) * XTP : BT + ((cv - 32) * 8) * XTP;
#pragma unroll 1
        for (int pass = 0; pass < 2; ++pass) {
            const int t0 = 8 * (tg + 8 * pass);
            u16x8 rows[12];
#pragma unroll
            for (int i = 0; i < 12; ++i) { const int sq = s0 + t0 + i - 2;
                if (sq >= 0 && sq < SEQL) rows[i] = *(const u16x8*)(P + (size_t)(b * SEQL + sq) * NPC + XBCOFF + ch); else rows[i] = (u16x8){0, 0, 0, 0, 0, 0, 0, 0}; }
#pragma unroll
            for (int tt = 0; tt < 8; ++tt) {
                float a0[8];
                asm volatile("" : "+v"(rows[tt + 4]));
#pragma unroll
                for (int i = 0; i < 8; ++i) a0[i] = bb[i];
#pragma unroll
                for (int j = 0; j < 5; ++j)
#pragma unroll
                    for (int i = 0; i < 8; ++i) a0[i] += bf2f(rows[tt + j][i]) * w[j][i];
#pragma unroll
                for (int i = 0; i < 8; ++i) a0[i] = silu(a0[i]);
                v4u o; o.x = pk2(a0[0], a0[1]); o.y = pk2(a0[2], a0[3]); o.z = pk2(a0[4], a0[5]); o.w = pk2(a0[6], a0[7]);
                *(v4u*)(XA + (size_t)(row0 + t0 + tt) * 768 + ch) = o;
                if (cv < 40) {
#pragma unroll
                    for (int i = 0; i < 8; ++i) TT[i * XTP + t0 + tt] = (bf16)f2bf(a0[i]);
                }
            }
        }
    }
    {
        const int hh = F.wave & 3, dir = F.wave >> 2, h = g * 4 + hh;
        const float* DTRAW = (const float*)(F.ws + WS_DTRAW); float* DTV = (float*)(F.ws + WS_DTV); float* CS = (float*)(F.ws + WS_CS); float* TOT = (float*)(F.ws + WS_TOT);
        const float* pbias = dir ? F.in[I_DTBB] : F.in[I_DTBF]; const float* palog = dir ? F.in[I_ALOGB] : F.in[I_ALOGF];
        const float bias = pbias[h], A = -expf(palog[h]);
        float dt[2], av[2];
#pragma unroll
        for (int i = 0; i < 2; ++i) { const float xr = DTRAW[(size_t)(row0 + 2 * F.lane + i) * 16 + dir * 8 + h] + bias; dt[i] = xr > 20.f ? xr : log1pf(expf(xr)); av[i] = dt[i] * A; }
        float s = av[0] + av[1];
#pragma unroll
        for (int o = 1; o < 64; o <<= 1) { const float t = __shfl_up(s, o); if (F.lane >= o) s += t; }
        const float tot = __shfl(s, 63);
        float cs[2]; cs[1] = s; cs[0] = s - av[1];
#pragma unroll
        for (int i = 0; i < 2; ++i) { const int tl = 2 * F.lane + i; const size_t o = (size_t)(row0 + tl) * 16 + dir * 8 + h;
            const float cv = dir ? cs[i] - av[i] : cs[i];
            DTV[o] = dt[i]; CS[o] = cv;
            WF[(dir * 4 + hh) * 128 + tl] = (dir ? __expf(cv) : __expf(tot - cs[i])) * dt[i]; }
        if (F.lane == 0) TOT[(b * NCH + c) * 16 + dir * 8 + h] = tot;
    }
    __syncthreads();
    {
        const int hh = F.wave & 3, dir = F.wave >> 2, h = g * 4 + hh, l15 = F.lane & 15, lq = F.lane >> 4;
        f32x4 acc[4][4];
#pragma unroll
        for (int i = 0; i < 4; ++i)
#pragma unroll
            for (int j = 0; j < 4; ++j) acc[i][j] = (f32x4){0.f, 0.f, 0.f, 0.f};
#pragma unroll
        for (int ks = 0; ks < 4; ++ks) {
            const int k0 = 32 * ks + 8 * lq;
            const f32x4 w0 = *(const LAS f32x4*)(WF + (dir * 4 + hh) * 128 + k0), w1 = *(const LAS f32x4*)(WF + (dir * 4 + hh) * 128 + k0 + 4);
            bf16x8 af[4], bfr[4];
#pragma unroll
            for (int mt = 0; mt < 4; ++mt) af[mt] = *(const LAS bf16x8*)(XT + (hh * 64 + 16 * mt + l15) * XTP + k0);
#pragma unroll
            for (int nt = 0; nt < 4; ++nt) { const u16x8 raw = *(const LAS u16x8*)(BT + (16 * nt + l15) * XTP + k0);
                v4u pk; pk.x = pk2(bf2f(raw[0]) * w0.x, bf2f(raw[1]) * w0.y); pk.y = pk2(bf2f(raw[2]) * w0.z, bf2f(raw[3]) * w0.w);
                pk.z = pk2(bf2f(raw[4]) * w1.x, bf2f(raw[5]) * w1.y); pk.w = pk2(bf2f(raw[6]) * w1.z, bf2f(raw[7]) * w1.w);
                bfr[nt] = __builtin_bit_cast(bf16x8, pk); }
#pragma unroll
            for (int mt = 0; mt < 4; ++mt)
#pragma unroll
                for (int nt = 0; nt < 4; ++nt) acc[mt][nt] = MFMA16(af[mt], bfr[nt], acc[mt][nt]);
        }
        float* ST = (float*)(F.ws + WS_ST) + ((size_t)(((b * NCH + c) * 8 + h) * 2 + dir)) * 4096;
#pragma unroll
        for (int mt = 0; mt < 4; ++mt)
#pragma unroll
            for (int nt = 0; nt < 4; ++nt)
#pragma unroll
                for (int r = 0; r < 4; ++r) ST[(16 * mt + 4 * lq + r) * 64 + 16 * nt + l15] = acc[mt][nt][r];
    }
    __syncthreads();
}

__device__ __forceinline__ void ps_scan(Frame& F) {
    const float* ST = (const float*)(F.ws + WS_ST); const float* TOT = (const float*)(F.ws + WS_TOT); bf16* SIN = (bf16*)(F.ws + WS_SIN);
    for (int gt = F.vcu * 512 + F.tid; gt < 128 * 1024; gt += F.G * 512) {
        const int seq = gt >> 10, el = (gt & 1023) * 4, b = seq >> 4, h = (seq >> 1) & 7, dir = seq & 1;
        f32x4 st[16]; float et[16];
#pragma unroll
        for (int c = 0; c < 16; ++c) { st[c] = *(const f32x4*)(ST + ((size_t)(((b * NCH + c) * 8 + h) * 2 + dir)) * 4096 + el); et[c] = __expf(TOT[(b * NCH + c) * 16 + dir * 8 + h]); }
        f32x4 run = (f32x4){0.f, 0.f, 0.f, 0.f};
        if (dir == 0) {
#pragma unroll
            for (int c = 0; c < 16; ++c) { v2u o; o.x = pk2(run.x, run.y); o.y = pk2(run.z, run.w); *(v2u*)(SIN + ((size_t)(((b * NCH + c) * 8 + h) * 2 + dir)) * 4096 + el) = o; run = run * et[c] + st[c]; }
        } else {
#pragma unroll
            for (int c = 15; c >= 0; --c) { v2u o; o.x = pk2(run.x, run.y); o.y = pk2(run.z, run.w); *(v2u*)(SIN + ((size_t)(((b * NCH + c) * 8 + h) * 2 + dir)) * 4096 + el) = o; run = run * et[c] + st[c]; }
        }
    }
}

__device__ __forceinline__ void ssd_b_unit(Frame& F, int b, int c, int g, const XcdBarrier& wb, bool pend) {
    LAS bf16* XT2 = (LAS bf16*)F.lds;
    LAS bf16* SL = XT2 + 128 * XTP;
    LAS bf16* WL = SL + 4 * 64 * SLP;
    LAS float* AR = (LAS float*)(WL + 8 * 16 * XTP);
    const bf16* XA = (const bf16*)(F.ws + WS_XA); const bf16* P = (const bf16*)(F.ws + WS_P); bf16* AO = (bf16*)(F.ws + WS_AO);
    const float* DTV = (const float*)(F.ws + WS_DTV); const float* CS = (const float*)(F.ws + WS_CS); const float* TOT = (const float*)(F.ws + WS_TOT);
    const int row0 = b * SEQL + c * CHK, l15 = F.lane & 15, lq = F.lane >> 4, w = F.wave;
    bf16x8 cf[2];
#pragma unroll
    for (int ks = 0; ks < 2; ++ks) cf[ks] = *(const bf16x8*)(XA + (size_t)(row0 + 16 * w + l15) * 768 + 640 + g * 64 + 32 * ks + 8 * lq);
    f32x4 G[8];
#pragma unroll
    for (int j = 0; j < 8; ++j) { G[j] = (f32x4){0.f, 0.f, 0.f, 0.f};
#pragma unroll
        for (int ks = 0; ks < 2; ++ks) { const bf16x8 bfr = *(const bf16x8*)(XA + (size_t)(row0 + 16 * j + l15) * 768 + 512 + g * 64 + 32 * ks + 8 * lq); G[j] = MFMA16(cf[ks], bfr, G[j]); } }
    unsigned ygp[4][4][2];
    float ssq = 0.f;
#pragma unroll 1
    for (int hp = 0; hp < 2; ++hp) {
        __syncthreads();
        for (int v = F.tid; v < CHK * 16; v += 512) { const int tl = v >> 4, cv = v & 15;
            const u16x8 pv = *(const u16x8*)(XA + (size_t)(row0 + tl) * 768 + g * 256 + hp * 128 + cv * 8);
#pragma unroll
            for (int i = 0; i < 8; ++i) XT2[(cv * 8 + i) * XTP + tl] = pv[i]; }
        for (int v = F.tid; v < 1024; v += 512) { const int kind = v >> 8, hh2 = (v >> 7) & 1, tl = v & 127, h = g * 4 + hp * 2 + hh2;
            const size_t o = (size_t)(row0 + tl) * 16 + ((kind & 1) ? 8 : 0) + h;
            AR[v] = (kind < 2) ? CS[o] : DTV[o]; }
        if (pend) { xcd_wait(wb); pend = false; }
        { const int combo = F.tid >> 7, hh2 = combo & 1, dir = combo >> 1, h = g * 4 + hp * 2 + hh2, idx = (F.tid & 127) * 32, p = idx >> 6, n = idx & 63;
            const bf16* src = (const bf16*)(F.ws + WS_SIN) + ((size_t)(((b * NCH + c) * 8 + h) * 2 + dir)) * 4096 + idx;
            v4u t[4];
#pragma unroll
            for (int q = 0; q < 4; ++q) t[q] = *(const v4u*)(src + 8 * q);
#pragma unroll
            for (int q = 0; q < 4; ++q) *(LAS v4u*)(SL + (combo * 64 + p) * SLP + n + 8 * q) = t[q]; }
        __syncthreads();
#pragma unroll 1
        for (int hh2 = 0; hh2 < 2; ++hh2) {
            const int hd = hp * 2 + hh2, h = g * 4 + hd;
            const LAS float* csf = AR + (0 * 2 + hh2) * 128; const LAS float* ecsb = AR + (1 * 2 + hh2) * 128; const LAS float* dtf = AR + (2 * 2 + hh2) * 128; const LAS float* dtb = AR + (3 * 2 + hh2) * 128;
            v2u zq[4];
#pragma unroll
            for (int pt = 0; pt < 4; ++pt) zq[pt] = *(const v2u*)(P + (size_t)(row0 + 16 * w + l15) * NPC + ZOFF + h * 64 + 16 * pt + 4 * lq);
            const float totb = TOT[(b * NCH + c) * 16 + 8 + h], dsk = F.in[I_DSKIP][h];
            float csl[4], ecl[4];
#pragma unroll
            for (int r = 0; r < 4; ++r) { csl[r] = csf[16 * w + 4 * lq + r]; ecl[r] = ecsb[16 * w + 4 * lq + r]; }
            LAS bf16* wl = WL + w * 16 * XTP;
#pragma unroll
            for (int j = 0; j < 8; ++j) { const int s = 16 * j + l15; const float cs_s = csf[s], ec_s = ecsb[s], df = dtf[s], db = dtb[s];
#pragma unroll
                for (int r = 0; r < 4; ++r) { const int l = 16 * w + 4 * lq + r;
                    const float arg = (s < l) ? (csl[r] - cs_s) : (ec_s - ecl[r]); const float mul = (s < l) ? df : db;
                    float val = G[j][r] * __expf(arg) * mul; if (s == l) val = G[j][r] * (df + db);
                    wl[(4 * lq + r) * XTP + s] = (bf16)f2bf(val); } }
            LDS_WAIT(); asm volatile("" ::: "memory");
            f32x4 yd[4], yf[4], yb[4];
#pragma unroll
            for (int pt = 0; pt < 4; ++pt) { yd[pt] = (f32x4){0.f, 0.f, 0.f, 0.f}; yf[pt] = yd[pt]; yb[pt] = yd[pt]; }
#pragma unroll
            for (int ks = 0; ks < 4; ++ks) { const bf16x8 af = *(const LAS bf16x8*)(wl + l15 * XTP + 32 * ks + 8 * lq);
#pragma unroll
                for (int pt = 0; pt < 4; ++pt) { const bf16x8 bfr = *(const LAS bf16x8*)(XT2 + (hh2 * 64 + 16 * pt + l15) * XTP + 32 * ks + 8 * lq); yd[pt] = MFMA16(bfr, af, yd[pt]); } }
#pragma unroll
            for (int ks = 0; ks < 2; ++ks)
#pragma unroll
                for (int pt = 0; pt < 4; ++pt) {
                    const bf16x8 bf_ = *(const LAS bf16x8*)(SL + ((0 * 2 + hh2) * 64 + 16 * pt + l15) * SLP + 32 * ks + 8 * lq); yf[pt] = MFMA16(bf_, cf[ks], yf[pt]);
                    const bf16x8 bb_ = *(const LAS bf16x8*)(SL + ((1 * 2 + hh2) * 64 + 16 * pt + l15) * SLP + 32 * ks + 8 * lq); yb[pt] = MFMA16(bb_, cf[ks], yb[pt]); }
            float yt[4][4];
            { const int l = 16 * w + l15; const float ef = __expf(csf[l]), eb = __expf(totb - ecsb[l]);
#pragma unroll
                for (int pt = 0; pt < 4; ++pt) { const int p0 = 16 * pt + 4 * lq;
                    const v2u zz = zq[pt];
                    const float zf[4] = {__builtin_bit_cast(float, zz.x << 16), __builtin_bit_cast(float, zz.x & 0xffff0000u), __builtin_bit_cast(float, zz.y << 16), __builtin_bit_cast(float, zz.y & 0xffff0000u)};
#pragma unroll
                    for (int r = 0; r < 4; ++r) { const float xv = bf2f(XT2[(hh2 * 64 + p0 + r) * XTP + l]);
                        const float y = (yd[pt][r] + ef * yf[pt][r] + eb * yb[pt][r] + dsk * xv) * silu(zf[r]);
                        yt[pt][r] = y; ssq += y * y; } } }
            unsigned pk[4][2];
#pragma unroll
            for (int pt = 0; pt < 4; ++pt) { pk[pt][0] = pk2(yt[pt][0], yt[pt][1]); pk[pt][1] = pk2(yt[pt][2], yt[pt][3]); }
#define YG_COPY(HD) do { _Pragma("unroll") for (int pt = 0; pt < 4; ++pt) { ygp[HD][pt][0] = pk[pt][0]; ygp[HD][pt][1] = pk[pt][1]; } } while (0)
            if (hd == 0) YG_COPY(0); else if (hd == 1) YG_COPY(1); else if (hd == 2) YG_COPY(2); else YG_COPY(3);
#undef YG_COPY
        }
    }
    const float* ng = F.in[I_SSMG];
    ssq += __shfl_xor(ssq, 16); ssq += __shfl_xor(ssq, 32);
    { const float rstd = 1.0f / sqrtf(ssq * (1.f / 256.f) + EPSN); const int l = 16 * w + l15;
#pragma unroll
        for (int hd = 0; hd < 4; ++hd)
#pragma unroll
            for (int pt = 0; pt < 4; ++pt) { const int chn = g * 256 + hd * 64 + 16 * pt + 4 * lq; const f32x4 gg = *(const f32x4*)(ng + chn);
                const unsigned p01 = ygp[hd][pt][0], p23 = ygp[hd][pt][1];
                v2u o; o.x = pk2(__builtin_bit_cast(float, p01 << 16) * rstd * gg.x, __builtin_bit_cast(float, p01 & 0xffff0000u) * rstd * gg.y);
                o.y = pk2(__builtin_bit_cast(float, p23 << 16) * rstd * gg.z, __builtin_bit_cast(float, p23 & 0xffff0000u) * rstd * gg.w);
                *(v2u*)(AO + (size_t)(row0 + l) * 1024 + 512 + chn) = o; } }
    __syncthreads();
}

__device__ __forceinline__ void attn_finalize_rows(Frame& F) {
    const bf16* R0 = (const bf16*)(F.ws + WS_AORAW); const bf16* R1 = R0 + (size_t)MTOK * 512; bf16* AO = (bf16*)(F.ws + WS_AO);
    const float lam = ((const float*)(F.ws + WS_LAM))[0]; const float* sg = F.in[I_SUBLN];
    const int gw = F.vcu * NWAVES + F.wave, NGW = F.G * NWAVES;
    const int d0 = (F.lane & 15) * 8;
    float gv[8];
#pragma unroll
    for (int i = 0; i < 8; ++i) gv[i] = sg[d0 + i] * 0.8f;
    constexpr int R = 4;
    for (int m0 = gw * R; m0 < MTOK; m0 += NGW * R) {
        u16x8 a[R], bq[R];
#pragma unroll
        for (int r = 0; r < R; ++r) { a[r] = *(const u16x8*)(R0 + (size_t)(m0 + r) * 512 + F.lane * 8); bq[r] = *(const u16x8*)(R1 + (size_t)(m0 + r) * 512 + F.lane * 8); }
#pragma unroll
        for (int r = 0; r < R; ++r) {
            float d[8]; float ss = 0.f;
#pragma unroll
            for (int i = 0; i < 8; ++i) { d[i] = bf2f(a[r][i]) - lam * bf2f(bq[r][i]); ss += d[i] * d[i]; }
            ss += __shfl_xor(ss, 1); ss += __shfl_xor(ss, 2); ss += __shfl_xor(ss, 4); ss += __shfl_xor(ss, 8);
            const float rstd = 1.0f / sqrtf(ss * (1.f / 128.f) + EPSN);
            v4u o; o.x = pk2(d[0] * rstd * gv[0], d[1] * rstd * gv[1]); o.y = pk2(d[2] * rstd * gv[2], d[3] * rstd * gv[3]);
            o.z = pk2(d[4] * rstd * gv[4], d[5] * rstd * gv[5]); o.w = pk2(d[6] * rstd * gv[6], d[7] * rstd * gv[7]);
            *(v4u*)(AO + (size_t)(m0 + r) * 1024 + F.lane * 8) = o;
        }
    }
}

__device__ __forceinline__ void p6_fill(Frame& F) {
    LAS float* wT = (LAS float*)F.lds;
    const float* rw = F.in[I_ROUTW];
    { float tmp[32];
#pragma unroll
        for (int i = 0; i < 32; ++i) tmp[i] = rw[F.tid + 512 * i];
#pragma unroll
        for (int i = 0; i < 32; ++i) { const int idx = F.tid + 512 * i, k = idx >> 4, j = idx & 15; wT[j * 1024 + k] = tmp[i]; } }
}
__device__ __forceinline__ void p6_rows(Frame& F) {
    LAS float* wT = (LAS float*)F.lds;
    const bf16* x1 = (const bf16*)(F.ws + WS_X1); const float* gm = F.in[I_GFFN]; const float* MOD = (const float*)(F.ws + WS_MOD);
    unsigned char* H2 = F.ws + WS_H2; float* AFF = (float*)(F.ws + WS_AFF);
    const int gw = F.vcu * NWAVES + F.wave, NGW = F.G * NWAVES;
    constexpr int R = 4;
    for (int m0 = gw * R; m0 < MTOK; m0 += NGW * R) {
        const int b = m0 >> 11, t0 = m0 & 2047;
        f32x4 v[R][4]; float ss[R];
#pragma unroll
        for (int r = 0; r < R; ++r) { const GAS v2u* xr = (const GAS v2u*)(x1 + (size_t)(m0 + r) * 1024) + F.lane;
#pragma unroll
            for (int j = 0; j < 4; ++j) { const v2u y = __builtin_nontemporal_load(xr + 64 * j);
                v[r][j] = (f32x4){__builtin_bit_cast(float, y.x << 16), __builtin_bit_cast(float, y.x & 0xffff0000u), __builtin_bit_cast(float, y.y << 16), __builtin_bit_cast(float, y.y & 0xffff0000u)}; } }
#pragma unroll
        for (int r = 0; r < R; ++r) { float t = 0.f;
#pragma unroll
            for (int j = 0; j < 4; ++j) t += (v[r][j].x * v[r][j].x + v[r][j].y * v[r][j].y) + (v[r][j].z * v[r][j].z + v[r][j].w * v[r][j].w);
            ss[r] = t; }
#pragma unroll
        for (int o = 1; o < 64; o <<= 1) {
#pragma unroll
            for (int r = 0; r < R; ++r) ss[r] += __shfl_xor(ss[r], o); }
#pragma unroll
        for (int r = 0; r < R; ++r) ss[r] = 1.0f / sqrtf(ss[r] * (1.f / 1024.f) + EPSN);
#pragma unroll
        for (int j = 0; j < 4; ++j) { const int col = 256 * j + 4 * F.lane;
            const f32x4 g = *(const f32x4*)(gm + col), sh = *(const f32x4*)(MOD + b * 6144 + 3072 + col), sc = *(const f32x4*)(MOD + b * 6144 + 4096 + col);
#pragma unroll
            for (int r = 0; r < R; ++r) { v[r][j] = (v[r][j] * ss[r] * g) * (sc + 1.0f) + sh;
                ((GAS unsigned*)(H2 + (size_t)(m0 + r) * 1024) + F.lane)[64 * j] = pg8::pk_fp8x4(v[r][j].x, v[r][j].y, v[r][j].z, v[r][j].w); } }
#pragma unroll
        for (int r = 0; r < R; r += 2) {
            float p[16], q[16];
#pragma unroll
            for (int jj = 0; jj < 16; ++jj) { float t = 0.f, u = 0.f;
#pragma unroll
                for (int j = 0; j < 4; ++j) { const f32x4 w = *(const LAS f32x4*)(wT + jj * 1024 + 256 * j + 4 * F.lane);
                    t += (v[r][j].x * w.x + v[r][j].y * w.y) + (v[r][j].z * w.z + v[r][j].w * w.w); u += (v[r + 1][j].x * w.x + v[r + 1][j].y * w.y) + (v[r + 1][j].z * w.z + v[r + 1][j].w * w.w); }
                p[jj] = t; q[jj] = u; if ((jj & 3) == 3) asm volatile("" ::: "memory"); }
            const float lgs[2] = {reduce16(p, F.lane), reduce16(q, F.lane)};
#pragma unroll
            for (int rr = 0; rr < 2; ++rr) {
                const float lg = lgs[rr];
                float mx = lg;
                mx = fmaxf(mx, __shfl_xor(mx, 4)); mx = fmaxf(mx, __shfl_xor(mx, 8)); mx = fmaxf(mx, __shfl_xor(mx, 16)); mx = fmaxf(mx, __shfl_xor(mx, 32));
                const float ex = expf(lg - mx); float sm = ex;
                sm += __shfl_xor(sm, 4); sm += __shfl_xor(sm, 8); sm += __shfl_xor(sm, 16); sm += __shfl_xor(sm, 32);
                if ((F.lane & 3) == 0) AFF[((size_t)(b * NE + reduce16_index(F.lane))) * SEQL + t0 + r + rr] = ex / sm;
            }
        }
    }
}

__device__ __forceinline__ void topk_task(Frame& F, int pm) {
    const float* AFF = (const float*)(F.ws + WS_AFF); int* IDX = (int*)(F.ws + WS_IDX); float* GATE = (float*)(F.ws + WS_GATE); int* SLOT = (int*)(F.ws + WS_SLOT);
    const int b = pm & 7, e = pm >> 3, task = b * NE + e;
    unsigned v[32];
#pragma unroll
    for (int i = 0; i < 32; ++i) v[i] = __builtin_bit_cast(unsigned, AFF[(size_t)task * SEQL + i * 64 + F.lane]);
    unsigned T = 0u;
    for (int bit = 30; bit >= 0; --bit) { const unsigned cand = T | (1u << bit); int c = 0;
#pragma unroll
        for (int i = 0; i < 32; ++i) c += (v[i] >= cand) ? 1 : 0;
        int cnt = 0;
#pragma unroll
        for (int bb = 0; bb < 6; ++bb) cnt += __popcll(__ballot((c >> bb) & 1)) << bb;
        if (cnt >= CAP) T = cand; }
    int cgt = 0;
#pragma unroll
    for (int i = 0; i < 32; ++i) cgt += __popcll(__ballot(v[i] > T));
    const int need = CAP - cgt;
    const unsigned long long lt = (1ull << F.lane) - 1ull;
    int running = 0, eqrun = 0;
#pragma unroll
    for (int i = 0; i < 32; ++i) {
        const bool gt = v[i] > T, eq = v[i] == T;
        const unsigned long long eqm = __ballot(eq);
        const int eqrank = eqrun + __popcll(eqm & lt);
        const bool sel = gt || (eq && eqrank < need);
        const unsigned long long sm = __ballot(sel);
        const int slot = running + __popcll(sm & lt), t = i * 64 + F.lane;
        if (sel) { IDX[pm * CAP + slot] = b * SEQL + t; GATE[pm * CAP + slot] = __builtin_bit_cast(float, v[i]); }
        SLOT[(size_t)(b * SEQL + t) * NE + e] = sel ? pm * CAP + slot : -1;
        running += __popcll(sm); eqrun += __popcll(eqm);
    }
}
template <class Sched> __device__ __forceinline__ void topk_for_units(Frame& F, const Sched& S) {
    pg8::Unit u; int prev = -1, nt = 0;
    for (int i = 0; S.next(i, u); ++i) { if (u.pm != prev) { if ((nt & 7) == F.wave) topk_task(F, u.pm); prev = u.pm; ++nt; } }
    VM_WAIT(); __syncthreads();
}

__device__ __forceinline__ void p10_rows(Frame& F) {
    const bf16* x1 = (const bf16*)(F.ws + WS_X1); float* outp = F.out; const float* gf = F.in[I_GFIN]; const float* MOD = (const float*)(F.ws + WS_MOD);
    const unsigned char* Y = F.ws + WS_Y; const int* SLOT = (const int*)(F.ws + WS_SLOT);
    const int gw = F.vcu * NWAVES + F.wave, NGW = F.G * NWAVES;
    constexpr int R = 2;
    for (int m0 = gw * R; m0 < MTOK; m0 += NGW * R) {
        const int b = m0 >> 11;
        int sl[R]; unsigned mk[R];
#pragma unroll
        for (int r = 0; r < R; ++r) sl[r] = SLOT[(size_t)(m0 + r) * NE + (F.lane & 15)];
        f32x4 v[R][4], a[R][4];
#pragma unroll
        for (int r = 0; r < R; ++r) { const GAS v2u* xr = (const GAS v2u*)(x1 + (size_t)(m0 + r) * 1024) + F.lane;
#pragma unroll
            for (int j = 0; j < 4; ++j) { const v2u y0 = __builtin_nontemporal_load(xr + 64 * j);
                v[r][j] = (f32x4){__builtin_bit_cast(float, y0.x << 16), __builtin_bit_cast(float, y0.x & 0xffff0000u), __builtin_bit_cast(float, y0.y << 16), __builtin_bit_cast(float, y0.y & 0xffff0000u)};
                a[r][j] = (f32x4){0.f, 0.f, 0.f, 0.f}; } }
#pragma unroll
        for (int r = 0; r < R; ++r) mk[r] = (unsigned)__ballot(sl[r] >= 0) & 0xffffu;
        unsigned y[R][4][4]; float wq[R][4];
#pragma unroll
        for (int r = 0; r < R; ++r)
#pragma unroll
            for (int q = 0; q < 4; ++q) { const bool has = mk[r] != 0u; const int e = has ? __builtin_ctz(mk[r]) : 0; mk[r] &= mk[r] - 1u;
                const int srow = has ? __builtin_amdgcn_readlane(sl[r], e) : 0; wq[r][q] = has ? pg8::WSCALE_INV : 0.f; if (!has) mk[r] = 0u;
                const GAS unsigned* yr = (const GAS unsigned*)(Y + (size_t)srow * 1024) + F.lane;
#pragma unroll
                for (int j = 0; j < 4; ++j) y[r][q][j] = __builtin_nontemporal_load(yr + 64 * j); }
#pragma unroll
        for (int r = 0; r < R; ++r)
#pragma unroll
            for (int q = 0; q < 4; ++q)
#pragma unroll
                for (int j = 0; j < 4; ++j) { const unsigned yy = y[r][q][j]; const float w = wq[r][q];
                    const auto lo = __builtin_amdgcn_cvt_pk_f32_fp8((int)yy, false), hi = __builtin_amdgcn_cvt_pk_f32_fp8((int)yy, true);
                    a[r][j].x += w * lo[0]; a[r][j].y += w * lo[1]; a[r][j].z += w * hi[0]; a[r][j].w += w * hi[1]; }
#pragma unroll
        for (int r = 0; r < R; ++r) while (mk[r] != 0u) { const int e = __builtin_ctz(mk[r]); mk[r] &= mk[r] - 1u; const int srow = __builtin_amdgcn_readlane(sl[r], e);
            const GAS unsigned* yr = (const GAS unsigned*)(Y + (size_t)srow * 1024) + F.lane;
#pragma unroll
            for (int j = 0; j < 4; ++j) { const unsigned yy = yr[64 * j];
                const auto lo = __builtin_amdgcn_cvt_pk_f32_fp8((int)yy, false), hi = __builtin_amdgcn_cvt_pk_f32_fp8((int)yy, true);
                a[r][j].x += pg8::WSCALE_INV * lo[0]; a[r][j].y += pg8::WSCALE_INV * lo[1]; a[r][j].z += pg8::WSCALE_INV * hi[0]; a[r][j].w += pg8::WSCALE_INV * hi[1]; } }
        float ss[R];
#pragma unroll
        for (int r = 0; r < R; ++r) ss[r] = 0.f;
#pragma unroll
        for (int j = 0; j < 4; ++j) { const int col = 256 * j + 4 * F.lane; const f32x4 g2 = *(const f32x4*)(MOD + b * 6144 + 5120 + col);
#pragma unroll
            for (int r = 0; r < R; ++r) { v[r][j] = v[r][j] + g2 * a[r][j]; ss[r] += (v[r][j].x * v[r][j].x + v[r][j].y * v[r][j].y) + (v[r][j].z * v[r][j].z + v[r][j].w * v[r][j].w); } }
#pragma unroll
        for (int o = 1; o < 64; o <<= 1) {
#pragma unroll
            for (int r = 0; r < R; ++r) ss[r] += __shfl_xor(ss[r], o); }
#pragma unroll
        for (int j = 0; j < 4; ++j) { const int col = 256 * j + 4 * F.lane; const f32x4 g = *(const f32x4*)(gf + col);
#pragma unroll
            for (int r = 0; r < R; ++r) { const float rstd = 1.0f / sqrtf(ss[r] * (1.f / 1024.f) + EPSN); __builtin_nontemporal_store(v[r][j] * rstd * g, (GAS f32x4*)(outp + (size_t)(m0 + r) * 1024) + F.lane + 64 * j); } }
    }
}

struct Args { const float* in[27]; float* out; unsigned char* ws; int ph_lo, ph_hi; };
__global__ void __launch_bounds__(NWAVES * 64, 2) mk_fwd(Args args) {
    extern __shared__ __attribute__((aligned(16))) unsigned char lds[];
    Frame F;
    F.lds = (LAS unsigned char*)lds;
    F.MISC = (volatile LAS unsigned*)(F.lds + MISC_OFF);
    F.tid = threadIdx.x; F.lane = F.tid & 63; F.wave = __builtin_amdgcn_readfirstlane(F.tid >> 6);
    F.G = gridDim.x; { const int bx = blockIdx.x; F.vcu = (F.G % 8 == 0) ? (bx % 8) * (F.G / 8) + bx / 8 : bx; }
#pragma unroll
    for (int i = 0; i < 27; ++i) F.in[i] = args.in[i];
    F.out = args.out; F.ws = args.ws; F.ctl = (gu32*)(args.ws + WS_CTL);
    for (int u = F.tid; u < (LDS_BYTES - LDSCTL_OFF) / 4; u += NWAVES * 64) ((LAS unsigned*)(F.lds + LDSCTL_OFF))[u] = 0u;
    __syncthreads();
    XcdBarrier bar; bar.bar = (unsigned*)(F.ctl + CW_BAR); bar.x = 0; bar.st = nullptr;
    if (N_LAUNCHES != PER_PHASE) bar = xcd_barrier_post((unsigned*)(F.ctl + CW_BAR), F.MISC + 8);
    const int lo = args.ph_lo, hi = args.ph_hi;
#ifndef PH_MASK
#define PH_MASK 0x7ff
#endif
#define IN(k) (((PH_MASK >> (k)) & 1) && lo <= (k) && (k) < hi)
#define SEAM(k) do { if (IN(k) && IN((k) + 1)) xcd_barrier(bar); } while (0)

    BgConv bg;
    if (IN(0)) { p0_prologue(F); SEAM(0); }
    if (IN(1)) { p1_rows(F); SEAM(1); }
    if (IN(2)) {
        pg8::Gemm g{F.ws + WS_XN, F.ws + WS_WIN, 2048}; pg8::StaticOrder S; S.init(MTOK, 3072, F.G, (int)blockIdx.x);
        pg8::EpiP E{(bf16*)(F.ws + WS_P), NPC, 2, 0.125f * LOG2E, (float*)(F.ws + WS_DTRAW)}; pg8::ARowDense AR;
        pg8::gemm_phase<pg8::EpiP, pg8::StaticOrder, pg8::ARowDense, true, false>(F.lds + RING_OFF, g, S, E, AR);
        if (IN(3)) { xcd_arrive(bar); bg.init(F); xcd_wait(bar); }
    }
    if (IN(3)) {
        const float* TAB = (const float*)(F.ws + WS_TAB);
        const attn2::bf16* P = (const attn2::bf16*)(F.ws + WS_P); attn2::bf16* AORAW = (attn2::bf16*)(F.ws + WS_AORAW);
#ifndef NO_ATTN
        if (!IN(2)) bg.init(F);
        int hprev = -1; float clo = 0.f, chi = 0.f;
        __syncthreads();
        for (int u = F.vcu; u < 512; u += F.G) {
            const int bhm = u >> 3, qb = u & 7, b = bhm >> 3, h = (bhm >> 1) & 3, mp = bhm & 1;
            const float* tabsrc = nullptr;
            if (h != hprev) {
                tabsrc = TAB + h * 4096 - 256 + 2047; hprev = h;
                clo = __builtin_bit_cast(float, __builtin_amdgcn_readfirstlane(__builtin_bit_cast(int, TAB[h * 4096]))); chi = __builtin_bit_cast(float, __builtin_amdgcn_readfirstlane(__builtin_bit_cast(int, TAB[h * 4096 + 4094]))); }
            const size_t rowb = (size_t)b * SEQL;
            attn2::attn_unit(P + (rowb + qb * 256) * NPC + QOFF + h * 128 + mp * 64, P + rowb * NPC + KOFF + h * 128 + mp * 64, P + rowb * NPC + VOFF + h * 128,
                             AORAW + (size_t)mp * MTOK * 512 + (rowb + qb * 256) * 512 + h * 128, qb, (char*)lds + RING_OFF, tabsrc, clo, chi, bg);
        }
        bg.drain();
#endif
        __syncthreads();
#ifndef NO_SSDA
        for (int u = F.vcu; u < 256; u += F.G) ssd_a_unit(F, u >> 5, (u >> 1) & 15, u & 1);
#endif
        SEAM(3);
    }
    if (IN(4)) { ps_scan(F); attn_finalize_rows(F); if (IN(5)) xcd_arrive(bar); }
    if (IN(5)) {
        { bool pend = IN(4); for (int u = F.vcu; u < 256; u += F.G) { ssd_b_unit(F, u >> 5, (u >> 1) & 15, u & 1, bar, pend); pend = false; } if (pend) xcd_wait(bar); }
        SEAM(5);
    }
    if (IN(6)) {
        pg8::Gemm g{F.ws + WS_AO, F.ws + WS_WOUT, 2048}; pg8::StaticOrder S; S.init(MTOK, 1024, F.G, (int)blockIdx.x);
        pg8::EpiX1 E{F.in[I_X], (bf16*)(F.ws + WS_X1), (const float*)(F.ws + WS_MOD)}; pg8::ARowDense AR;
        pg8::gemm_phase<pg8::EpiX1, pg8::StaticOrder, pg8::ARowDense, true, false>(F.lds + RING_OFF, g, S, E, AR);
        if (IN(7)) { xcd_arrive(bar); p6_fill(F); xcd_wait(bar); }
    }
    if (IN(7)) { if (!IN(6)) { p6_fill(F); __syncthreads(); } p6_rows(F); SEAM(7); }
    if (IN(8)) {
        pg8::Gemm g{F.ws + WS_H2, F.ws + WS_WGU, 1024}; pg8::MoeOrder<22> S{F.G, F.vcu};
        pg8::EpiHid E{F.ws + WS_HID}; pg8::ARowGather AR{(const int*)(F.ws + WS_IDX)};
        topk_for_units(F, S);
        pg8::gemm_phase<pg8::EpiHid, pg8::MoeOrder<22>, pg8::ARowGather, true, true>(F.lds + RING_OFF, g, S, E, AR);
        SEAM(8);
    }
    if (IN(9)) {
        pg8::Gemm g{F.ws + WS_HID, F.ws + WS_WD, FFD}; pg8::MoeOrder<4> S{F.G, F.vcu};
        pg8::EpiY E{F.ws + WS_Y, (const float*)(F.ws + WS_GATE)}; pg8::ARowDenseVO AR;
        pg8::gemm_phase<pg8::EpiY, pg8::MoeOrder<4>, pg8::ARowDenseVO, true, true>(F.lds + RING_OFF, g, S, E, AR);
        SEAM(9);
    }
    if (IN(10)) { p10_rows(F); }
#undef IN
#undef SEAM
}

extern "C" void kernel_launch(void* const* d_in, const int* in_sizes, int n_in, void* d_out, int out_size, void* d_ws, size_t ws_size, hipStream_t stream) {
    static int grid = 0;
    if (grid == 0) {
        if (n_in != 27 || in_sizes[0] != MTOK * DMODEL || out_size != MTOK * DMODEL || ws_size < WS_END) {
            fprintf(stderr, "kernel_launch: unexpected shapes: n_in %d, in0 %d, out %d, ws %zu (need %zu); nothing launched\n", n_in, n_in > 0 ? in_sizes[0] : -1, out_size, ws_size, (size_t)WS_END); grid = -1; return; }
        int dev = 0, cus = 0, per_cu = 0;
        if (hipGetDevice(&dev) != hipSuccess || hipDeviceGetAttribute(&cus, hipDeviceAttributeMultiprocessorCount, dev) != hipSuccess) { grid = -1; return; }
        if (hipFuncSetAttribute((const void*)mk_fwd, hipFuncAttributeMaxDynamicSharedMemorySize, LDS_BYTES) != hipSuccess) { fprintf(stderr, "kernel_launch: hipFuncSetAttribute failed\n"); grid = -1; return; }
        if (hipOccupancyMaxActiveBlocksPerMultiprocessor(&per_cu, (const void*)mk_fwd, NWAVES * 64, LDS_BYTES) != hipSuccess || per_cu < 1) { fprintf(stderr, "kernel_launch: occupancy query says %d\n", per_cu); per_cu = 1; }
        (void)hipGetLastError();
        grid = cus;
        if (grid > 256) grid = 256;
    }
    if (grid < 0) return;
    (void)hipMemsetAsync((char*)d_ws + WS_CTL, 0, CTL_ZERO_BYTES, stream);
    Args a{};
    for (int i = 0; i < 27; ++i) a.in[i] = (const float*)d_in[i];
    a.out = (float*)d_out; a.ws = (unsigned char*)d_ws;
    if (N_LAUNCHES == 1) { a.ph_lo = 0; a.ph_hi = PER_PHASE; hipLaunchKernelGGL(mk_fwd, dim3(grid), dim3(NWAVES * 64), LDS_BYTES, stream, a); }
    else { for (int li = 0; li < PER_PHASE; ++li) { a.ph_lo = li; a.ph_hi = li + 1; hipLaunchKernelGGL(mk_fwd, dim3(grid), dim3(NWAVES * 64), LDS_BYTES, stream, a); } }
}
```

```cpp
#include <hip/hip_runtime.h>
#include <hip/hip_bf16.h>
#include <cstdio>
#include <cstdint>
#include <cmath>

#ifndef MK_N_LAUNCHES
#define MK_N_LAUNCHES 1
#endif

namespace pg8 {
#define PG8_LAS __attribute__((address_space(3)))
typedef unsigned short bf16_t;
typedef short bf16x8 __attribute__((ext_vector_type(8)));
typedef float f32x4 __attribute__((ext_vector_type(4)));
typedef unsigned u32x4 __attribute__((ext_vector_type(4)));
constexpr int BM = 256, BK = 64, HALF = 128, HTB = HALF * BK * 2  , STAGE_BYTES = 8 * HTB, NXCD = 8, WGM = 8;

__host__ __device__ __forceinline__ int lds_byte(int r, int c) { const int st = (r >> 4) * 2 + (c >> 5), rr = r & 15, cc = c & 31, ob = rr * 64 + cc * 2; return st * 1024 + (ob ^ (((ob >> 9) & 1) << 5)); }
__host__ __device__ __forceinline__ void stage_rc(int b, int& R, int& C) { const int st = b / 1024, sb = b % 1024, swz = sb ^ (((sb >> 9) & 1) << 5); R = (st >> 1) * 16 + swz / 64; C = (st & 1) * 32 + (swz % 64) / 2; }
__host__ __device__ __forceinline__ int perm32(int rho) { const int n = rho >> 4, i = rho & 15; return 8 * (i >> 2) + 4 * n + (i & 3); }

struct Unit { int pm, pn; };
struct Gemm { const void* A; const void* Bt; int KB; };

struct StaticOrder {
    int nM, nN, nwg, G, c;
    __host__ __device__ void init(int M, int N, int G_, int c_) { nM = M / BM; nN = N / BM; nwg = nM * nN; G = G_; c = c_; }
    __host__ __device__ bool next(int i, Unit& u) const {
        const long L = (long)i * G + c; if (L >= nwg) return false;
        int wgid = (int)L; { const int q = nwg / NXCD, r = nwg % NXCD, xcd = wgid % NXCD, off = wgid / NXCD; wgid = (xcd < r ? xcd * (q + 1) : r * (q + 1) + (xcd - r) * q) + off; }
        const int nig = WGM * nN, gid = wgid / nig, fm = gid * WGM, gsz = (nM - fm) < WGM ? (nM - fm) : WGM;
        u.pm = fm + ((wgid % nig) % gsz); u.pn = (wgid % nig) / gsz; return true;
    }
};
template <int NJ> struct MoeOrder {
    int G, v;
    __device__ bool next(int i, Unit& u) const {
        if (G == 256) {
            const int x = v >> 5, s = v & 31, b = s & 7, q = s >> 3, gi = 4 * i + q;
            if (gi >= 2 * NJ) return false;
            const int e = 2 * x + gi / NJ, j = gi % NJ; u.pm = e * 8 + b; u.pn = e * NJ + j; return true;
        } else {
            const long L = (long)i * G + v; if (L >= 16L * NJ * 8) return false;
            const int b = (int)(L & 7), gi = (int)(L >> 3), e = gi / NJ, j = gi % NJ; u.pm = e * 8 + b; u.pn = e * NJ + j; return true;
        }
    }
};
struct ARowDense { static constexpr bool GATHER = false; __device__ __forceinline__ unsigned row(const Unit& u, int r) const { return (unsigned)(u.pm * BM + r); } };
struct ARowDenseVO { static constexpr bool GATHER = true; __device__ __forceinline__ unsigned row(const Unit& u, int r) const { return (unsigned)(u.pm * BM + r); } };
struct ARowGather { static constexpr bool GATHER = true; const int* idx; __device__ __forceinline__ unsigned row(const Unit& u, int r) const { return (unsigned)idx[u.pm * BM + r]; } };

__device__ __forceinline__ unsigned cvt_pk_bf16(float lo, float hi) { unsigned r; asm volatile("v_cvt_pk_bf16_f32 %0, %1, %2" : "=v"(r) : "v"(lo), "v"(hi)); return r; }

struct EpiP {
    static constexpr bool PERM = true;
    bf16_t* O; int ldc; int nscale; float scale0; float* dtraw;
    __device__ __forceinline__ void operator()(const f32x4 (&acc)[2][2][4][2], const Unit& u, int wr, int wc, int fr, int fq) const {
        const int row0 = u.pm * BM + wr * 64 + fr, col0 = u.pn * BM + wc * 32 + 8 * fq;
        if (u.pn == 11) {
            if (wc == 0 && fq < 2) {
#pragma unroll
                for (int ai = 0; ai < 2; ++ai)
#pragma unroll
                    for (int m = 0; m < 4; ++m) { float* dp = dtraw + (size_t)(row0 + ai * HALF + m * 16) * 16 + 8 * fq; *(f32x4*)dp = acc[ai][0][m][0]; *(f32x4*)(dp + 4) = acc[ai][0][m][1]; } }
            return; }
        const float sc = (u.pn < nscale) ? scale0 : 1.f;
#pragma unroll
        for (int ai = 0; ai < 2; ++ai)
#pragma unroll
            for (int m = 0; m < 4; ++m) { bf16_t* rowp = O + (size_t)(row0 + ai * HALF + m * 16) * ldc + col0;
#pragma unroll
                for (int bj = 0; bj < 2; ++bj) { const f32x4 v0 = acc[ai][bj][m][0] * sc, v1 = acc[ai][bj][m][1] * sc;
                    u32x4 w; w.x = cvt_pk_bf16(v0[0], v0[1]); w.y = cvt_pk_bf16(v0[2], v0[3]); w.z = cvt_pk_bf16(v1[0], v1[1]); w.w = cvt_pk_bf16(v1[2], v1[3]);
                    *(u32x4*)(rowp + bj * HALF) = w; } }
    }
};
struct EpiX1 {
    static constexpr bool PERM = true;
    const float* x; bf16_t* out; const float* mod;
    __device__ __forceinline__ void operator()(const f32x4 (&acc)[2][2][4][2], const Unit& u, int wr, int wc, int fr, int fq) const {
        const int row0 = u.pm * BM + wr * 64 + fr, col0 = u.pn * BM + wc * 32 + 8 * fq;
        const float* g1 = mod + (size_t)((u.pm * BM) >> 11) * 6144 + 2048;
        f32x4 gv[2][2];
#pragma unroll
        for (int bj = 0; bj < 2; ++bj)
#pragma unroll
            for (int n = 0; n < 2; ++n) gv[bj][n] = *(const f32x4*)(g1 + col0 + bj * HALF + n * 4);
#pragma unroll
        for (int ai = 0; ai < 2; ++ai)
#pragma unroll
            for (int m = 0; m < 4; ++m) { const size_t off = (size_t)(row0 + ai * HALF + m * 16) * 1024 + col0;
#pragma unroll
                for (int bj = 0; bj < 2; ++bj) { const f32x4 x0 = __builtin_nontemporal_load((const f32x4*)(x + off + bj * HALF)), x1v = __builtin_nontemporal_load((const f32x4*)(x + off + bj * HALF + 4));
                    const f32x4 v0 = x0 + gv[bj][0] * acc[ai][bj][m][0], v1 = x1v + gv[bj][1] * acc[ai][bj][m][1];
                    u32x4 w; w.x = cvt_pk_bf16(v0[0], v0[1]); w.y = cvt_pk_bf16(v0[2], v0[3]); w.z = cvt_pk_bf16(v1[0], v1[1]); w.w = cvt_pk_bf16(v1[2], v1[3]);
                    *(u32x4*)(out + off + bj * HALF) = w; } }
    }
};
__device__ __forceinline__ float silu_f(float v) { return v * __builtin_amdgcn_rcpf(1.f + __builtin_amdgcn_exp2f(-1.4426950408889634f * v)); }
typedef unsigned u32x2 __attribute__((ext_vector_type(2)));
__device__ __forceinline__ unsigned pk_fp8x4(float a, float b, float c, float d) { unsigned w = 0u; w = __builtin_amdgcn_cvt_pk_fp8_f32(a, b, w, false); w = __builtin_amdgcn_cvt_pk_fp8_f32(c, d, w, true); return w; }
constexpr float WSCALE = 64.f, WSCALE_INV = 1.f / 64.f;
struct EpiHid {
    static constexpr bool PERM = true;
    unsigned char* O;
    __device__ __forceinline__ void operator()(const f32x4 (&acc)[2][2][4][2], const Unit& u, int wr, int wc, int fr, int fq) const {
        const int row0 = u.pm * BM + wr * 64 + fr, col0 = (u.pn % 22) * HALF + wc * 32 + 8 * fq;
#pragma unroll
        for (int ai = 0; ai < 2; ++ai)
#pragma unroll
            for (int m = 0; m < 4; ++m) { unsigned char* rowp = O + (size_t)(row0 + ai * HALF + m * 16) * 2816 + col0;
                f32x4 h0, h1;
#pragma unroll
                for (int i = 0; i < 4; ++i) { h0[i] = silu_f(acc[ai][0][m][0][i] * WSCALE_INV) * (acc[ai][1][m][0][i] * WSCALE_INV); h1[i] = silu_f(acc[ai][0][m][1][i] * WSCALE_INV) * (acc[ai][1][m][1][i] * WSCALE_INV); }
                u32x2 w; w.x = pk_fp8x4(h0[0], h0[1], h0[2], h0[3]); w.y = pk_fp8x4(h1[0], h1[1], h1[2], h1[3]);
                *(u32x2*)rowp = w; }
    }
};
struct EpiY {
    static constexpr bool PERM = true;
    unsigned char* O; const float* gate;
    __device__ __forceinline__ void operator()(const f32x4 (&acc)[2][2][4][2], const Unit& u, int wr, int wc, int fr, int fq) const {
        const int row0 = u.pm * BM + wr * 64 + fr, col0 = (u.pn & 3) * BM + wc * 32 + 8 * fq;
#pragma unroll
        for (int ai = 0; ai < 2; ++ai)
#pragma unroll
            for (int m = 0; m < 4; ++m) { const int row = row0 + ai * HALF + m * 16; const float gt = gate[row]; unsigned char* rowp = O + (size_t)row * 1024 + col0;
#pragma unroll
                for (int bj = 0; bj < 2; ++bj) { const f32x4 v0 = acc[ai][bj][m][0] * gt, v1 = acc[ai][bj][m][1] * gt;
                    u32x2 w; w.x = pk_fp8x4(v0[0], v0[1], v0[2], v0[3]); w.y = pk_fp8x4(v1[0], v1[1], v1[2], v1[3]);
                    *(u32x2*)(rowp + bj * HALF) = w; }
                asm volatile("" ::: "memory"); }
    }
};

typedef int v4i_t __attribute__((ext_vector_type(4)));
typedef int v8i_t __attribute__((ext_vector_type(8)));
template <bool FP8> struct FragT;
template <> struct FragT<false> { struct A4 { bf16x8 v[4][2]; }; struct B2 { bf16x8 v[2][2]; }; };
template <> struct FragT<true>  { struct A4 { v8i_t v[4]; };    struct B2 { v8i_t v[2]; }; };
template <class Epi, class Sched, class ARow, bool ALIGN_EPI, bool FP8>
__device__ __forceinline__ void gemm_phase(PG8_LAS unsigned char* lds, const Gemm g, const Sched& S, const Epi& E, const ARow& AR) {
    constexpr bool GATHER = ARow::GATHER;
    const int tid = threadIdx.x, wid = __builtin_amdgcn_readfirstlane(tid >> 6), lane = tid & 63, wr = wid >> 2, wc = wid & 3, fr = lane & 15, fq = lane >> 4;
    const int KB = g.KB, nt = KB / 128;
    int pR[2], pC[2]; unsigned voffA[2], voffB[2];
#pragma unroll
    for (int i = 0; i < 2; ++i) { int R, C; stage_rc(tid * 16 + i * 8192, R, C); const int Rb = Epi::PERM ? ((R & ~31) + perm32(R & 31)) : R;
        pR[i] = R; pC[i] = C; voffA[i] = (unsigned)(R * KB + C * 2); voffB[i] = (unsigned)(Rb * KB + C * 2); }
    const size_t kstep = (size_t)(BK * 2);
    const size_t hstep = (size_t)HALF * KB;
    const size_t tstep = 2 * hstep;
    const unsigned ldsw = (unsigned)wid * 1024u;
    const int aoff = lds_byte(wr * 64 + fr, fq * 8), boff = lds_byte(wc * 32 + fr, fq * 8);
#define PG8_SA(b, h) (((b) * 2 + (h)) * HTB)
#define PG8_SB(b, h) ((4 + (b) * 2 + (h)) * HTB)
#define PG8_STAGE(bufoff, gbase, voff) do { _Pragma("unroll") for (int _i = 0; _i < 2; ++_i) \
        __builtin_amdgcn_global_load_lds((const unsigned*)((const char*)(gbase) + (voff)[_i]), (PG8_LAS unsigned*)(lds + (bufoff) + ldsw + _i * 8192), 16, 0, 0); } while (0)
#define PG8_STAGE_A(bufoff, kp, h) do { if constexpr (GATHER) { _Pragma("unroll") for (int _i = 0; _i < 2; ++_i) \
        __builtin_amdgcn_global_load_lds((const unsigned*)((const char*)(kp) + voAc[h][_i]), (PG8_LAS unsigned*)(lds + (bufoff) + ldsw + _i * 8192), 16, 0, 0); } \
        else { PG8_STAGE(bufoff, (kp) + (h) * hstep, voffA); } } while (0)
#define PG8_LD16(off) (*(const PG8_LAS v4i_t*)(lds + (off)))
#define PG8_LDA(dst, b, h) do { _Pragma("unroll") for (int m = 0; m < 4; ++m) { \
        if constexpr (FP8) { dst.v[m] = __builtin_shufflevector(PG8_LD16(PG8_SA(b, h) + aoff + m * 2048), PG8_LD16(PG8_SA(b, h) + aoff + m * 2048 + 1024), 0, 1, 2, 3, 4, 5, 6, 7); } \
        else { _Pragma("unroll") for (int k = 0; k < 2; ++k) dst.v[m][k] = *(const PG8_LAS bf16x8*)(lds + PG8_SA(b, h) + aoff + m * 2048 + k * 1024); } } } while (0)
#define PG8_LDB(dst, b, h) do { _Pragma("unroll") for (int n = 0; n < 2; ++n) { \
        if constexpr (FP8) { dst.v[n] = __builtin_shufflevector(PG8_LD16(PG8_SB(b, h) + boff + n * 2048), PG8_LD16(PG8_SB(b, h) + boff + n * 2048 + 1024), 0, 1, 2, 3, 4, 5, 6, 7); } \
        else { _Pragma("unroll") for (int k = 0; k < 2; ++k) dst.v[n][k] = *(const PG8_LAS bf16x8*)(lds + PG8_SB(b, h) + boff + n * 2048 + k * 1024); } } } while (0)
#define PG8_MMA(ai, bj, At, Bt) do { __builtin_amdgcn_s_setprio(1); _Pragma("unroll") for (int m = 0; m < 4; ++m) _Pragma("unroll") for (int n = 0; n < 2; ++n) { \
        if constexpr (FP8) { acc[ai][bj][m][n] = __builtin_amdgcn_mfma_scale_f32_16x16x128_f8f6f4(Bt.v[n], At.v[m], acc[ai][bj][m][n], 0, 0, 0, 0x7f7f7f7f, 0, 0x7f7f7f7f); } \
        else { _Pragma("unroll") for (int k = 0; k < 2; ++k) acc[ai][bj][m][n] = __builtin_amdgcn_mfma_f32_16x16x32_bf16(Bt.v[n][k], At.v[m][k], acc[ai][bj][m][n], 0, 0, 0); } } \
        __builtin_amdgcn_s_setprio(0); } while (0)
#define PG8_WAIT_V(n) asm volatile("s_waitcnt vmcnt(" #n ")" ::: "memory")
#define PG8_WAIT_L(n) asm volatile("s_waitcnt lgkmcnt(" #n ")" ::: "memory")
#define PG8_BAR __builtin_amdgcn_s_barrier()
#define PG8_SCHED __builtin_amdgcn_sched_barrier(0)
#define PG8_VOA(dst, u) do { _Pragma("unroll") for (int _h = 0; _h < 2; ++_h) _Pragma("unroll") for (int _i = 0; _i < 2; ++_i) \
        dst[_h][_i] = AR.row(u, _h * HALF + pR[_i]) * (unsigned)KB + (unsigned)pC[_i] * 2u; } while (0)
    Unit cur, nxt; int ui = 0;
    if (!S.next(0, cur)) return;
    f32x4 acc[2][2][4][2];
#pragma unroll
    for (int a = 0; a < 2; ++a)
#pragma unroll
        for (int b = 0; b < 2; ++b)
#pragma unroll
            for (int m = 0; m < 4; ++m)
#pragma unroll
                for (int n = 0; n < 2; ++n) acc[a][b][m][n] = (f32x4){0.f, 0.f, 0.f, 0.f};
    typedef typename FragT<FP8>::A4 FragA; typedef typename FragT<FP8>::B2 FragB;
    FragA At; FragB B0, B1;
    unsigned voAc[2][2], voAn[2][2];
    if constexpr (GATHER) { PG8_VOA(voAc, cur); }
    const char* cA = GATHER ? (const char*)g.A : (const char*)g.A + (size_t)cur.pm * tstep;
    const char* cB = (const char*)g.Bt + (size_t)cur.pn * tstep;
    PG8_STAGE(PG8_SB(0, 0), cB, voffB); PG8_STAGE(PG8_SB(0, 1), cB + hstep, voffB); PG8_STAGE_A(PG8_SA(0, 0), cA, 0); PG8_STAGE_A(PG8_SA(0, 1), cA, 1);
    if (wr == 1) PG8_BAR;
    PG8_WAIT_V(2); PG8_BAR;
    PG8_STAGE(PG8_SB(1, 0), cB + kstep, voffB); PG8_STAGE_A(PG8_SA(1, 0), cA + kstep, 0); PG8_STAGE(PG8_SB(1, 1), cB + hstep + kstep, voffB);
    PG8_WAIT_V(6); PG8_BAR;
    for (;;) {
        const bool has_next = S.next(ui + 1, nxt);
        if constexpr (GATHER) {
            if (has_next && nxt.pm != cur.pm) { PG8_VOA(voAn, nxt); }
            else {
#pragma unroll
                for (int h = 0; h < 2; ++h)
#pragma unroll
                    for (int i = 0; i < 2; ++i) voAn[h][i] = voAc[h][i]; }
        }
        const char* nA = (!GATHER && has_next) ? (const char*)g.A + (size_t)nxt.pm * tstep : cA;
        const char* nB = has_next ? (const char*)g.Bt + (size_t)nxt.pn * tstep : cB;
#pragma unroll 1
        for (int t = 0; t < nt; t += 2) {
            const bool last = (t == nt - 2);
            const char* a1 = cA + (size_t)(t + 1) * kstep;
            const char* a2 = last ? nA : cA + (size_t)(t + 2) * kstep; const char* b2 = last ? nB : cB + (size_t)(t + 2) * kstep;
            const char* a3 = a2 + kstep; const char* b3 = b2 + kstep;
            PG8_LDB(B0, 0, 0); PG8_LDB(B1, 0, 1); PG8_SCHED; PG8_LDA(At, 0, 0); PG8_STAGE_A(PG8_SA(1, 1), a1, 1);
            if constexpr (GATHER) { if (last) {
#pragma unroll
                for (int h = 0; h < 2; ++h)
#pragma unroll
                    for (int i = 0; i < 2; ++i) voAc[h][i] = voAn[h][i]; } }
            PG8_WAIT_V(8); PG8_WAIT_L(0); PG8_BAR; PG8_MMA(0, 0, At, B0); PG8_MMA(0, 1, At, B1); PG8_BAR; PG8_SCHED;
            PG8_LDA(At, 0, 1); PG8_STAGE(PG8_SB(0, 0), b2, voffB); PG8_STAGE(PG8_SB(0, 1), b2 + hstep, voffB); PG8_STAGE_A(PG8_SA(0, 0), a2, 0);
            PG8_WAIT_V(8); PG8_WAIT_L(0); PG8_BAR; PG8_MMA(1, 0, At, B0); PG8_MMA(1, 1, At, B1); PG8_BAR; PG8_SCHED;
            PG8_LDB(B0, 1, 0); PG8_LDB(B1, 1, 1); PG8_SCHED; PG8_LDA(At, 1, 0); PG8_STAGE_A(PG8_SA(0, 1), a2, 1);
            PG8_WAIT_V(8); PG8_WAIT_L(0); PG8_BAR; PG8_MMA(0, 0, At, B0); PG8_MMA(0, 1, At, B1); PG8_BAR; PG8_SCHED;
            PG8_LDA(At, 1, 1); PG8_STAGE(PG8_SB(1, 0), b3, voffB); PG8_STAGE(PG8_SB(1, 1), b3 + hstep, voffB); PG8_STAGE_A(PG8_SA(1, 0), a3, 0);
            PG8_WAIT_V(8); PG8_WAIT_L(0); PG8_BAR; PG8_MMA(1, 0, At, B0); PG8_MMA(1, 1, At, B1); PG8_BAR; PG8_SCHED;
        }
        if constexpr (ALIGN_EPI) { if (wr == 0) PG8_BAR; }
        E(acc, cur, wr, wc, fr, fq);
        if (!has_next) break;
#pragma unroll
        for (int a = 0; a < 2; ++a)
#pragma unroll
            for (int b = 0; b < 2; ++b)
#pragma unroll
                for (int m = 0; m < 4; ++m)
#pragma unroll
                    for (int n = 0; n < 2; ++n) acc[a][b][m][n] = (f32x4){0.f, 0.f, 0.f, 0.f};
        cur = nxt; cA = nA; cB = nB; ++ui;
        if constexpr (ALIGN_EPI) { if (wr == 1) PG8_BAR; }
    }
    PG8_WAIT_V(0);
    if constexpr (!ALIGN_EPI) { if (wr == 0) PG8_BAR; }
    PG8_BAR;
#undef PG8_SA
#undef PG8_SB
#undef PG8_STAGE
#undef PG8_STAGE_A
#undef PG8_LDA
#undef PG8_LDB
#undef PG8_MMA
#undef PG8_LD16
#undef PG8_WAIT_V
#undef PG8_WAIT_L
#undef PG8_BAR
#undef PG8_SCHED
#undef PG8_VOA
}
}

namespace attn2 {
using bf16 = __hip_bfloat16;
using bf16x8 = __attribute__((ext_vector_type(8))) short;
using s16x4  = __attribute__((ext_vector_type(4))) short;
using f32x16 = __attribute__((ext_vector_type(16))) float;
using u32x4  = __attribute__((ext_vector_type(4))) unsigned;
constexpr int NW = 8, QBLK = 32, KVBLK = 64, SEQ = 2048, LDP = 2816, LDO = 512;
constexpr float THRL = 11.5f;
constexpr int SHM_V = KVBLK * 128 * 2, SHM_K = KVBLK * 64 * 2;
constexpr int LDS_WS = 2 * SHM_V + 2 * SHM_K, LDS_TAB = LDS_WS + NW * 64 * 4, LDS_BYTES = LDS_TAB + 16384;
#define KSWZ64(row, colB) ((row) * 128 + ((colB) ^ ((((row) >> 1) & 7) << 4)))
#define SBAR() __builtin_amdgcn_sched_barrier(0)
typedef __attribute__((address_space(3))) const float* lds_fptr;
__device__ __forceinline__ int crow(int r, int hi) { return (r & 3) + 8 * (r >> 2) + 4 * hi; }
__device__ __forceinline__ unsigned cvtpk(float lo, float hi) { unsigned r; asm volatile("v_cvt_pk_bf16_f32 %0, %1, %2" : "=v"(r) : "v"(lo), "v"(hi)); return r; }
__device__ __forceinline__ float add_bias(f32x16& p0, f32x16& p1, int t, int qw0, int qabs, int hi, lds_fptr tab, float clo, float chi) {
  const int relmin = 64 * t - (qw0 + 31), relmax = 64 * t + 63 - qw0;
  if (relmax <= -128 || relmin >= 128) return relmin >= 128 ? chi : clo;
  const lds_fptr tp = tab + (64 * t - qabs + 256 + 4 * hi);
#pragma unroll
  for (int r = 0; r < 16; ++r) { const int o = (r & 3) + 8 * (r >> 2); p0[r] += tp[o]; p1[r] += tp[o + 32]; }
  return 0.f;
}
__device__ __forceinline__ void partialSM(f32x16& p0, f32x16& p1, float cb, float& m_reg, float& alpha) {
  float pmax = p0[0];
#pragma unroll
  for (int r = 1; r < 16; ++r) pmax = fmaxf(pmax, p0[r]);
#pragma unroll
  for (int r = 0; r < 16; ++r) pmax = fmaxf(pmax, p1[r]);
  { auto rr = __builtin_amdgcn_permlane32_swap(__float_as_uint(pmax), __float_as_uint(pmax), false, false);
    pmax = fmaxf(__uint_as_float(rr[0]), __uint_as_float(rr[1])) + cb; }
  float mn;
  if (__builtin_expect(__all(pmax - m_reg <= THRL), 1)) { mn = m_reg; alpha = 1.f; }
  else { mn = fmaxf(m_reg, pmax); alpha = __builtin_amdgcn_exp2f(m_reg - mn); m_reg = mn; }
  const float sub = mn - cb;
#pragma unroll
  for (int r = 0; r < 16; ++r) { p0[r] -= sub; p1[r] -= sub; }
#pragma unroll
  for (int r = 0; r < 16; ++r) p0[r] = __builtin_amdgcn_exp2f(p0[r]);
}
__device__ __forceinline__ void finishSM(f32x16& p0, f32x16& p1, float alpha, float& l_reg, bf16x8& pa0, bf16x8& pa1, bf16x8& pa2, bf16x8& pa3) {
#pragma unroll
  for (int r = 0; r < 16; ++r) p1[r] = __builtin_amdgcn_exp2f(p1[r]);
  float ps = 0;
#pragma unroll
  for (int r = 0; r < 16; ++r) ps += p0[r];
#pragma unroll
  for (int r = 0; r < 16; ++r) ps += p1[r];
  { auto rr = __builtin_amdgcn_permlane32_swap(__float_as_uint(ps), __float_as_uint(ps), false, false);
    ps = __uint_as_float(rr[0]) + __uint_as_float(rr[1]); }
  l_reg = l_reg * alpha + ps;
#define PK4(P, BASE, OUT) do { unsigned a0 = cvtpk(P[BASE + 0], P[BASE + 1]), a1 = cvtpk(P[BASE + 2], P[BASE + 3]);   \
    unsigned b0 = cvtpk(P[BASE + 4], P[BASE + 5]), b1 = cvtpk(P[BASE + 6], P[BASE + 7]);                              \
    auto r0 = __builtin_amdgcn_permlane32_swap(a0, b0, false, false); auto r1 = __builtin_amdgcn_permlane32_swap(a1, b1, false, false); \
    u32x4 w = {r0[0], r1[0], r0[1], r1[1]}; OUT = *reinterpret_cast<bf16x8*>(&w); } while (0)
  PK4(p0, 0, pa0); PK4(p0, 8, pa1); PK4(p1, 0, pa2); PK4(p1, 8, pa3);
#undef PK4
}
__device__ __forceinline__ void qkt(f32x16& p0, f32x16& p1, const bf16* Ks, const bf16x8* qr, int r32, int hi) {
  p0 = f32x16{}; p1 = f32x16{};
#pragma unroll
  for (int d0 = 0; d0 < 4; ++d0) { const int cb = (d0 * 16 + hi * 8) * 2;
    bf16x8 b0 = *reinterpret_cast<const bf16x8*>((const char*)Ks + KSWZ64(r32, cb));
    bf16x8 b1 = *reinterpret_cast<const bf16x8*>((const char*)Ks + KSWZ64(32 + r32, cb));
    p0 = __builtin_amdgcn_mfma_f32_32x32x16_bf16(b0, qr[d0], p0, 0, 0, 0);
    p1 = __builtin_amdgcn_mfma_f32_32x32x16_bf16(b1, qr[d0], p1, 0, 0, 0); }
}
__device__ __forceinline__ int v_st(int k, int c) { const int kk = (k & ~0xC) | ((k & 4) << 1) | ((k & 8) >> 1); return ((kk >> 3) * 4 + (c >> 5)) * 512 + ((kk & 7) * 32 + (c & 31)) * 2; }
__device__ __forceinline__ int v_rd_base(int lane) { return ((lane & 3) << 3) | (((lane >> 2) & 3) << 6) | (((lane >> 4) & 1) << 5) | (((lane >> 5) & 1) << 8); }
constexpr int v_rd_off(int d0, int ks, int half) { return d0 * 512 + ks * 4096 + half * 2048; }
template <int OFF> __device__ __forceinline__ s16x4 tr_read(int vb) {
  s16x4 r; asm volatile("ds_read_b64_tr_b16 %0, %1 offset:%2" : "=&v"(r) : "v"(vb), "i"(OFF) : "memory"); return r;
}
template <int D0> __device__ __forceinline__ void pv_one(f32x16& od, int vb, bf16x8 pa0, bf16x8 pa1, bf16x8 pa2, bf16x8 pa3) {
  const s16x4 l0 = tr_read<v_rd_off(D0, 0, 0)>(vb), h0 = tr_read<v_rd_off(D0, 0, 1)>(vb), l1 = tr_read<v_rd_off(D0, 1, 0)>(vb), h1 = tr_read<v_rd_off(D0, 1, 1)>(vb);
  const s16x4 l2 = tr_read<v_rd_off(D0, 2, 0)>(vb), h2 = tr_read<v_rd_off(D0, 2, 1)>(vb), l3 = tr_read<v_rd_off(D0, 3, 0)>(vb), h3 = tr_read<v_rd_off(D0, 3, 1)>(vb);
  asm volatile("s_waitcnt lgkmcnt(0)" ::: "memory"); SBAR();
#define PK(L, H) (bf16x8){L[0], L[1], L[2], L[3], H[0], H[1], H[2], H[3]}
  od = __builtin_amdgcn_mfma_f32_32x32x16_bf16(pa0, PK(l0, h0), od, 0, 0, 0);
  od = __builtin_amdgcn_mfma_f32_32x32x16_bf16(pa1, PK(l1, h1), od, 0, 0, 0);
  od = __builtin_amdgcn_mfma_f32_32x32x16_bf16(pa2, PK(l2, h2), od, 0, 0, 0);
  od = __builtin_amdgcn_mfma_f32_32x32x16_bf16(pa3, PK(l3, h3), od, 0, 0, 0);
#undef PK
}
__device__ __forceinline__ void pv_d0(f32x16* o, int vb, bf16x8 pa0, bf16x8 pa1, bf16x8 pa2, bf16x8 pa3) {
  pv_one<0>(o[0], vb, pa0, pa1, pa2, pa3); pv_one<1>(o[1], vb, pa0, pa1, pa2, pa3); pv_one<2>(o[2], vb, pa0, pa1, pa2, pa3); pv_one<3>(o[3], vb, pa0, pa1, pa2, pa3);
}
template <class Hook>
__device__ __forceinline__ void attn_unit(const bf16* __restrict__ Qb, const bf16* __restrict__ Kh, const bf16* __restrict__ Vh, bf16* __restrict__ Ob, int qb, char* lds, const float* tabsrc, float clo, float chi, Hook& hk) {
  const int tid = threadIdx.x, wid = __builtin_amdgcn_readfirstlane(tid >> 6), lane = tid & 63, r32 = lane & 31, hi = lane >> 5;
  bf16* V_lds = (bf16*)lds; bf16* K_lds = (bf16*)(lds + 2 * SHM_V);
  float* ws = (float*)(lds + LDS_WS) + wid * 64; float* li_l = ws; float* al_l = ws + 32;
  const lds_fptr tab = (lds_fptr)((__attribute__((address_space(3))) const char*)lds + LDS_TAB);
  float m_reg = -1e30f, l_reg = 0; f32x16 o[4] = {}; bf16x8 qr[4];
  const bf16* Qw = Qb + (long)(wid * QBLK + r32) * LDP + hi * 8;
#pragma unroll
  for (int d0 = 0; d0 < 4; ++d0) qr[d0] = *reinterpret_cast<const bf16x8*>(Qw + d0 * 16);
  const int qw0 = qb * 256 + wid * QBLK, qabs = qw0 + r32;
  const int kr = tid >> 3, kc = (tid & 7) * 8, kst = KSWZ64(kr, kc * 2);
  const int sr = tid >> 4, sc = (tid & 15) * 8, vst0 = v_st(sr, sc), vst1 = v_st(32 + sr, sc);
  const int vb0 = (int)(uintptr_t)V_lds + v_rd_base(lane);
  struct { bf16x8 vs0, vs1, ks0; } sr_[2];
  const unsigned voV = (unsigned)((sr * LDP + sc) * 2), voK = (unsigned)((kr * LDP + kc) * 2);
#define GLD16(d, vo, sb) asm volatile("global_load_dwordx4 %0, %1, %2" : "=v"(d) : "v"(vo), "s"(sb) : "memory")
#define SLOAD(i, k0) do { const bf16* vt_ = Vh + (long)(k0) * LDP; GLD16(sr_[i].vs0, voV, vt_); GLD16(sr_[i].vs1, voV, vt_ + 32 * LDP); GLD16(sr_[i].ks0, voK, Kh + (long)(k0) * LDP); } while (0)
#define FWAIT(nh) do { if ((nh) == 6) asm volatile("s_waitcnt vmcnt(9)" ::: "memory"); else if ((nh) == 4) asm volatile("s_waitcnt vmcnt(7)" ::: "memory"); \
    else if ((nh) == 2) asm volatile("s_waitcnt vmcnt(5)" ::: "memory"); else asm volatile("s_waitcnt vmcnt(3)" ::: "memory"); } while (0)
#define SWRITE(b, i) do { *(bf16x8*)((char*)V_lds + (b) * SHM_V + vst0) = sr_[i].vs0; *(bf16x8*)((char*)V_lds + (b) * SHM_V + vst1) = sr_[i].vs1; \
    *(bf16x8*)((char*)K_lds + (b) * SHM_K + kst) = sr_[i].ks0; } while (0)
#define SWAIT() asm volatile("s_waitcnt vmcnt(3)" ::: "memory")
#define ABAR() asm volatile("s_waitcnt lgkmcnt(0)\n\ts_barrier" ::: "memory")
#define RESC(a) do { if (__any((a) < 1.f)) { if (hi == 0) al_l[r32] = (a); asm volatile("s_waitcnt lgkmcnt(0)" ::: "memory"); \
    _Pragma("unroll") for (int d = 0; d < 4; ++d) _Pragma("unroll") for (int r = 0; r < 16; ++r) o[d][r] *= al_l[crow(r, hi)]; } } while (0)
  f32x16 pA0, pA1, pB0, pB1; float alA, alB; bf16x8 pa0, pa1, pa2, pa3; constexpr int NT = SEQ / KVBLK;
  constexpr int SE = 0, SO = 1;
  SLOAD(SE, 0); SLOAD(SO, KVBLK);
  if (tabsrc) ((float*)(lds + LDS_TAB))[tid] = tabsrc[tid];
  asm volatile("s_waitcnt vmcnt(0)" ::: "memory"); SWRITE(0, SE); SWRITE(1, SO); ABAR();
  SLOAD(SE, 2 * KVBLK);
  asm volatile("" ::: "memory"); int nh = hk.stepB();
  qkt(pA0, pA1, K_lds, qr, r32, hi); { const float cb = add_bias(pA0, pA1, 0, qw0, qabs, hi, tab, clo, chi); partialSM(pA0, pA1, cb, m_reg, alA); }
  for (int j = 1; j + 1 < NT; j += 2) {
    SBAR(); qkt(pB0, pB1, (bf16*)((char*)K_lds + SHM_K), qr, r32, hi);
    finishSM(pA0, pA1, alA, l_reg, pa0, pa1, pa2, pa3); SBAR();
    SLOAD(SO, (j + 2) * KVBLK); SBAR();
    pv_d0(o, vb0, pa0, pa1, pa2, pa3); { const float cb = add_bias(pB0, pB1, j, qw0, qabs, hi, tab, clo, chi); partialSM(pB0, pB1, cb, m_reg, alB); }
    ABAR(); FWAIT(nh); SWRITE(0, SE);
    asm volatile("" ::: "memory"); hk.issue_half(1);
    RESC(alB); ABAR();
    SBAR(); qkt(pA0, pA1, K_lds, qr, r32, hi);
    finishSM(pB0, pB1, alB, l_reg, pa0, pa1, pa2, pa3); SBAR();
    SLOAD(SE, (j + 3 < NT ? j + 3 : NT - 1) * KVBLK); SBAR();
    pv_d0(o, vb0 + (int)SHM_V, pa0, pa1, pa2, pa3); { const float cb = add_bias(pA0, pA1, j + 1, qw0, qabs, hi, tab, clo, chi); partialSM(pA0, pA1, cb, m_reg, alA); }
    ABAR(); SWAIT(); SWRITE(1, SO);
    asm volatile("" ::: "memory"); nh = hk.stepB();
    RESC(alA); ABAR();
  }
  asm volatile("" ::: "memory"); hk.issue_half(1);
  SBAR(); qkt(pB0, pB1, (bf16*)((char*)K_lds + SHM_K), qr, r32, hi);
  finishSM(pA0, pA1, alA, l_reg, pa0, pa1, pa2, pa3); SBAR();
  pv_d0(o, vb0, pa0, pa1, pa2, pa3); { const float cb = add_bias(pB0, pB1, NT - 1, qw0, qabs, hi, tab, clo, chi); partialSM(pB0, pB1, cb, m_reg, alB); }
  ABAR(); RESC(alB);
  finishSM(pB0, pB1, alB, l_reg, pa0, pa1, pa2, pa3); SBAR();
  pv_d0(o, vb0 + (int)SHM_V, pa0, pa1, pa2, pa3);
  if (hi == 0) li_l[r32] = l_reg; asm volatile("s_waitcnt lgkmcnt(0)" ::: "memory");
  float rli[16];
#pragma unroll
  for (int r = 0; r < 16; ++r) rli[r] = __builtin_amdgcn_rcpf(li_l[crow(r, hi)]);
  bf16* Ow = Ob + (long)(wid * QBLK) * LDO;
#pragma unroll
  for (int r = 0; r < 16; ++r) { const int orow = crow(r, hi);
#pragma unroll
    for (int d0 = 0; d0 < 4; ++d0) Ow[(long)orow * LDO + d0 * 32 + r32] = __float2bfloat16(o[d0][r] * rli[r]); }
  ABAR();
#undef SLOAD
#undef GLD16
#undef FWAIT
#undef SWRITE
#undef SWAIT
#undef RESC
#undef ABAR
}
#undef SBAR
#undef KSWZ64
}

constexpr int NWAVES = 8;
constexpr int N_LAUNCHES = MK_N_LAUNCHES;
constexpr int PER_PHASE = 11;
constexpr int NB = 8, SEQL = 2048, DMODEL = 1024, MTOK = NB * SEQL;
constexpr int NPC = 2816, NINC = 2832;
constexpr int QOFF = 0, KOFF = 512, VOFF = 1024, ZOFF = 1536, XBCOFF = 2048;
constexpr int NE = 16, CAP = 256, FFD = 2816;
constexpr int NCH = 16, CHK = 128;
constexpr float EPSN = 1e-6f;
constexpr float LOG2E = 1.4426950408889634f;

constexpr size_t MiB = 1u << 20;
constexpr size_t WS_CTL = 0, CTL_ZERO_BYTES = 64 * 1024;
constexpr size_t WS_MOD = 1 * MiB;
constexpr size_t WS_TAB = 1 * MiB + 256 * 1024;
constexpr size_t WS_LAM = 1 * MiB + 512 * 1024;
constexpr size_t WS_DUMMY = 1 * MiB + 768 * 1024;
constexpr size_t WS_TOT = 1 * MiB + 576 * 1024;
constexpr size_t WS_WIN = 2 * MiB, WS_WOUT = 8 * MiB, WS_WGU = 10 * MiB, WS_WD = 186 * MiB;
constexpr size_t WS_H2 = 274 * MiB;
constexpr size_t WS_SIN = 290 * MiB;
constexpr size_t WS_Y = 306 * MiB;
constexpr size_t WS_ST = 306 * MiB;
constexpr size_t WS_AORAW = 338 * MiB;
constexpr size_t WS_HID = 370 * MiB;
constexpr size_t WS_P = 370 * MiB;
constexpr size_t WS_XN = 458 * MiB;
constexpr size_t WS_X1 = 458 * MiB;
constexpr size_t WS_AO = 490 * MiB;
constexpr size_t WS_XA = 522 * MiB;
constexpr size_t WS_DTRAW = 546 * MiB, WS_DTV = 547 * MiB, WS_CS = 548 * MiB, WS_AFF = 549 * MiB;
constexpr size_t WS_IDX = 550 * MiB, WS_GATE = 550 * MiB + 512 * 1024, WS_SLOT = 551 * MiB, WS_END = 552 * MiB;
constexpr int CW_BAR = 4096;

constexpr int RING_OFF = 0, RING_BYTES = 131072;
constexpr int LDSCTL_OFF = 146432, MISC_OFF = LDSCTL_OFF + 320;
constexpr int LDS_BYTES = 147456;

#define GAS __attribute__((address_space(1)))
#define LAS __attribute__((address_space(3)))
typedef unsigned short bf16;
typedef unsigned v4u __attribute__((ext_vector_type(4)));
typedef unsigned v2u __attribute__((ext_vector_type(2)));
typedef float f32x4 __attribute__((ext_vector_type(4)));
typedef short bf16x8 __attribute__((ext_vector_type(8)));
typedef unsigned short u16x8 __attribute__((ext_vector_type(8)));
typedef GAS unsigned gu32;
#define RLX_AGENT __ATOMIC_RELAXED, __HIP_MEMORY_SCOPE_AGENT
#define LDS_WAIT() asm volatile("s_waitcnt lgkmcnt(0)" ::: "memory")
#define VM_WAIT() asm volatile("s_waitcnt vmcnt(0)" ::: "memory")
__device__ __forceinline__ unsigned f2bf(float f) { unsigned u = __builtin_bit_cast(unsigned, f); return (u + 0x7fffu + ((u >> 16) & 1u)) >> 16; }
__device__ __forceinline__ unsigned pk2(float lo, float hi) { return f2bf(lo) | (f2bf(hi) << 16); }
__device__ __forceinline__ float bf2f(unsigned short h) { return __builtin_bit_cast(float, (unsigned)h << 16); }
__device__ __forceinline__ float silu(float v) { return v / (1.f + __expf(-v)); }

#define XB_TMO      128
#define XB_XCNT(j)  (256  + 64 * (j))
#define XB_XSUB(j)  (1280 + 64 * (j))
#define XB_XGEN(j)  (2304 + 64 * (j))
#define XB_TOP      3328
#define XB_TOPGEN   3392
#define XCD_BAR_WORDS 3456
#define XB_SPIN_CAP (1u << 18)

__device__ __forceinline__ unsigned xb_ld(unsigned* p)              { return __hip_atomic_load(p, __ATOMIC_RELAXED, __HIP_MEMORY_SCOPE_AGENT); }
__device__ __forceinline__ unsigned xb_add(unsigned* p, unsigned v) { return __hip_atomic_fetch_add(p, v, __ATOMIC_RELAXED, __HIP_MEMORY_SCOPE_AGENT); }
__device__ __forceinline__ unsigned xb_xcc_id() { return (unsigned)__builtin_amdgcn_s_getreg((3 << 11) | 20) & 0xFu; }
#define XB_SPIN(cond, bar) do { unsigned _sp = 0; while (cond) { __builtin_amdgcn_s_sleep(1); \
    if ((++_sp & 255u) == 0u) { if (xb_ld(&(bar)[XB_TMO])) break; if (_sp > XB_SPIN_CAP) { atomicAdd(&(bar)[XB_TMO], 1u); break; } } } } while (0)

struct XcdBarrier {
    unsigned* bar; unsigned x;
    volatile LAS unsigned* st;
};

__device__ __forceinline__ XcdBarrier xcd_barrier_post(unsigned* bar, volatile LAS unsigned* st) {
    XcdBarrier b; b.bar = bar; b.x = xb_xcc_id(); b.st = st;
    if (threadIdx.x == 0) (void)xb_add(&bar[XB_XCNT(b.x)], 1u);
    return b;
}
__device__ __forceinline__ void xcd_barrier_complete(unsigned* bar, unsigned x, unsigned& nloc, unsigned& nx) {
    const unsigned G = gridDim.x * gridDim.y * gridDim.z;
    unsigned sum, cnt, mine, sp = 0u;
    for (;;) {
        sum = 0u; cnt = 0u; mine = 0u;
#pragma unroll
        for (unsigned j = 0; j < 16; ++j) { const unsigned c = xb_ld(&bar[XB_XCNT(j)]); sum += c; cnt += (c > 0u) ? 1u : 0u; mine = (j == x) ? c : mine; }
        if (sum == G) break;
        __builtin_amdgcn_s_sleep(1);
        if ((++sp & 255u) == 0u) { if (xb_ld(&bar[XB_TMO])) break; if (sp > XB_SPIN_CAP) { atomicAdd(&bar[XB_TMO], 1u); break; } }
    }
    nloc = mine > 0u ? mine : 1u; nx = cnt > 0u ? cnt : 1u;
}

__device__ __forceinline__ void xcd_barrier(const XcdBarrier& b) {
    asm volatile("s_waitcnt vmcnt(0)" ::: "memory");
    __syncthreads();
    if (threadIdx.x == 0) {
        unsigned* bar = b.bar;
        __builtin_amdgcn_s_waitcnt(0);
        unsigned nloc = b.st[0], nx = b.st[1];
        if (nloc == 0u) { xcd_barrier_complete(bar, b.x, nloc, nx); b.st[0] = nloc; b.st[1] = nx; }
        const unsigned old = xb_add(&bar[XB_XSUB(b.x)], 1u);
        const unsigned gen = old / nloc;
        if (old + 1u == (gen + 1u) * nloc) {
            __builtin_amdgcn_fence(__ATOMIC_RELEASE, "agent");
            asm volatile("s_waitcnt vmcnt(0)" ::: "memory");
            const unsigned og = xb_add(&bar[XB_TOP], 1u);
            const unsigned tg = og / nx;
            if (og + 1u == (tg + 1u) * nx) xb_add(&bar[XB_TOPGEN], 1u);
            else XB_SPIN(xb_ld(&bar[XB_TOPGEN]) == tg, bar);
            __builtin_amdgcn_fence(__ATOMIC_ACQUIRE, "agent");
            xb_add(&bar[XB_XGEN(b.x)], 1u);
            asm volatile("s_waitcnt vmcnt(0)" ::: "memory");
        } else {
            XB_SPIN(xb_ld(&bar[XB_XGEN(b.x)]) == gen, bar);
            __builtin_amdgcn_fence(__ATOMIC_ACQUIRE, "agent");
            asm volatile("s_waitcnt vmcnt(0)" ::: "memory");
        }
    }
    __syncthreads();
}


__device__ __forceinline__ void xcd_arrive(const XcdBarrier& b) {
    asm volatile("s_waitcnt vmcnt(0)" ::: "memory");
    __syncthreads();
    if (threadIdx.x == 0) {
        unsigned* bar = b.bar;
        __builtin_amdgcn_s_waitcnt(0);
        unsigned nloc = b.st[0], nx = b.st[1];
        if (nloc == 0u) { xcd_barrier_complete(bar, b.x, nloc, nx); b.st[0] = nloc; b.st[1] = nx; }
        const unsigned old = xb_add(&bar[XB_XSUB(b.x)], 1u);
        const unsigned gen = old / nloc;
        if (old + 1u == (gen + 1u) * nloc) {
            __builtin_amdgcn_fence(__ATOMIC_RELEASE, "agent");
            asm volatile("s_waitcnt vmcnt(0)" ::: "memory");
            const unsigned og = xb_add(&bar[XB_TOP], 1u);
            const unsigned tg = og / nx;
            if (og + 1u == (tg + 1u) * nx) xb_add(&bar[XB_TOPGEN], 1u);
            else XB_SPIN(xb_ld(&bar[XB_TOPGEN]) == tg, bar);
            __builtin_amdgcn_fence(__ATOMIC_ACQUIRE, "agent");
            xb_add(&bar[XB_XGEN(b.x)], 1u);
            asm volatile("s_waitcnt vmcnt(0)" ::: "memory");
            b.st[4] = 1u;
        } else { b.st[4] = 0u; b.st[5] = gen; }
    }
}
__device__ __forceinline__ void xcd_wait(const XcdBarrier& b) {
    if (threadIdx.x == 0) {
        if (b.st[4] == 0u) { unsigned* bar = b.bar; const unsigned gen = b.st[5];
            XB_SPIN(xb_ld(&bar[XB_XGEN(b.x)]) == gen, bar);
            __builtin_amdgcn_fence(__ATOMIC_ACQUIRE, "agent");
            asm volatile("s_waitcnt vmcnt(0)" ::: "memory"); }
    }
    __syncthreads();
}

struct Frame {
    LAS unsigned char* lds;
    volatile LAS unsigned* MISC;
    gu32* ctl;
    int tid, lane, wave;
    int vcu, G;
    const float* in[27]; float* out; unsigned char* ws;
};
enum { I_X = 0, I_C, I_ADAW, I_ADAB, I_GMIX, I_GFFN, I_GFIN, I_WIN, I_LQ1, I_LK1, I_LQ2, I_LK2, I_SUBLN, I_RELT, I_CONVW, I_CONVB, I_DTBF, I_DTBB, I_ALOGF, I_ALOGB, I_DSKIP, I_SSMG, I_WOUT, I_ROUTW, I_WGATE, I_WUP, I_WDOWN };

__device__ __forceinline__ float wave_sum(float v) {
#pragma unroll
    for (int o = 1; o < 64; o <<= 1) v += __shfl_xor(v, o);
    return v;
}
__device__ __forceinline__ float reduce16(const float (&p)[16], int lane) {
    float q8[8], q4[4], q2[2], q1;
    const bool u5 = (lane & 32) != 0, u4 = (lane & 16) != 0, u3 = (lane & 8) != 0, u2 = (lane & 4) != 0;
#pragma unroll
    for (int i = 0; i < 8; ++i) { const float send = u5 ? p[i] : p[i + 8], keep = u5 ? p[i + 8] : p[i]; q8[i] = keep + __shfl_xor(send, 32); }
#pragma unroll
    for (int i = 0; i < 4; ++i) { const float send = u4 ? q8[i] : q8[i + 4], keep = u4 ? q8[i + 4] : q8[i]; q4[i] = keep + __shfl_xor(send, 16); }
#pragma unroll
    for (int i = 0; i < 2; ++i) { const float send = u3 ? q4[i] : q4[i + 2], keep = u3 ? q4[i + 2] : q4[i]; q2[i] = keep + __shfl_xor(send, 8); }
    { const float send = u2 ? q2[0] : q2[1], keep = u2 ? q2[1] : q2[0]; q1 = keep + __shfl_xor(send, 4); }
    q1 += __shfl_xor(q1, 2); q1 += __shfl_xor(q1, 1);
    return q1;
}
__device__ __forceinline__ int reduce16_index(int lane) { return ((lane >> 5) & 1) * 8 + ((lane >> 4) & 1) * 4 + ((lane >> 3) & 1) * 2 + ((lane >> 2) & 1); }

constexpr int P0_ITEMS_DENSE = 16 * 89 + 16 * 32, P0_ITEMS_ALL = P0_ITEMS_DENSE + 3 * 16 * 1408;
struct P0Item { const float* src; unsigned char* dst; int ldw, pitch, fp8, nv; };
__device__ __forceinline__ void p0_load(const P0Item& d, float (&v)[32], int lane) {
    const int cl = (lane & 31) < d.nv ? (lane & 31) : (lane & 15);
#pragma unroll
    for (int i = 0; i < 32; ++i) { const int kk = 2 * i + (lane >> 5); v[i] = __builtin_nontemporal_load(d.src + (size_t)kk * d.ldw + cl); }
}
__device__ __forceinline__ void p0_store(const P0Item& d, const float (&v)[32], LAS float* scr, int lane) {
#pragma unroll
    for (int i = 0; i < 32; ++i) { const int kk = 2 * i + (lane >> 5); scr[kk * 33 + (lane & 31)] = v[i]; }
    LDS_WAIT(); asm volatile("" ::: "memory");
    if (d.fp8) {
#pragma unroll
        for (int j = 0; j < 2; ++j) { const int id = lane + 64 * j, n = id >> 2, kc = id & 3; const LAS float* s = scr + (16 * kc) * 33 + n;
            v4u o;
            o.x = pg8::pk_fp8x4(s[0 * 33] * pg8::WSCALE, s[1 * 33] * pg8::WSCALE, s[2 * 33] * pg8::WSCALE, s[3 * 33] * pg8::WSCALE);
            o.y = pg8::pk_fp8x4(s[4 * 33] * pg8::WSCALE, s[5 * 33] * pg8::WSCALE, s[6 * 33] * pg8::WSCALE, s[7 * 33] * pg8::WSCALE);
            o.z = pg8::pk_fp8x4(s[8 * 33] * pg8::WSCALE, s[9 * 33] * pg8::WSCALE, s[10 * 33] * pg8::WSCALE, s[11 * 33] * pg8::WSCALE);
            o.w = pg8::pk_fp8x4(s[12 * 33] * pg8::WSCALE, s[13 * 33] * pg8::WSCALE, s[14 * 33] * pg8::WSCALE, s[15 * 33] * pg8::WSCALE);
            __builtin_nontemporal_store(o, (GAS v4u*)(d.dst + (size_t)n * d.pitch + 16 * kc)); }
    } else {
        const int c = lane & 7;
#pragma unroll
        for (int j = 0; j < 4; ++j) { const int n = (lane >> 3) + 8 * j; const LAS float* s = scr + (8 * c) * 33 + n;
            v4u o; o.x = pk2(s[0 * 33], s[1 * 33]); o.y = pk2(s[2 * 33], s[3 * 33]); o.z = pk2(s[4 * 33], s[5 * 33]); o.w = pk2(s[6 * 33], s[7 * 33]);
            __builtin_nontemporal_store(o, (GAS v4u*)(d.dst + (size_t)n * d.pitch + 16 * c)); }
    }
    LDS_WAIT(); asm volatile("" ::: "memory");
}
__device__ __forceinline__ P0Item p0_decode(Frame& F, int it) {
    constexpr int I_IN = 16 * 89, I_OUT = 16 * 32, I_EXP = 1408, I_G = 16 * I_EXP;
    P0Item d; int r = it; d.nv = 32;
    if (r < I_IN) { const int kb = r / 89, nb = r % 89; d.nv = nb == 88 ? 16 : 32; d.src = F.in[I_WIN] + (size_t)(kb * 64) * NINC + nb * 32; d.ldw = NINC; d.pitch = 2048; d.fp8 = 0; d.dst = F.ws + WS_WIN + (size_t)(nb * 32) * 2048 + kb * 128; return d; } r -= I_IN;
    if (r < I_OUT) { const int kb = r / 32, nb = r % 32; d.src = F.in[I_WOUT] + (size_t)(kb * 64) * 1024 + nb * 32; d.ldw = 1024; d.pitch = 2048; d.fp8 = 0; d.dst = F.ws + WS_WOUT + (size_t)(nb * 32) * 2048 + kb * 128; return d; } r -= I_OUT;
    if (r < 2 * I_G) { const int up = r >= I_G; if (up) r -= I_G; const int e = r / I_EXP, rr = r % I_EXP, kb = rr / 88, nb = rr % 88, n0 = nb * 32;
        d.src = (up ? F.in[I_WUP] : F.in[I_WGATE]) + (size_t)e * 1024 * FFD + (size_t)(kb * 64) * FFD + n0; d.ldw = FFD; d.pitch = 1024; d.fp8 = 1;
        d.dst = F.ws + WS_WGU + (size_t)(e * 5632 + 256 * (n0 >> 7) + (n0 & 127) + (up ? 128 : 0)) * 1024 + kb * 64; return d; } r -= 2 * I_G;
    { const int e = r / I_EXP, rr = r % I_EXP, kb = rr / 32, nb = rr % 32;
        d.src = F.in[I_WDOWN] + (size_t)e * FFD * 1024 + (size_t)(kb * 64) * 1024 + nb * 32; d.ldw = 1024; d.pitch = FFD; d.fp8 = 1;
        d.dst = F.ws + WS_WD + (size_t)(e * 1024 + nb * 32) * FFD + kb * 64; return d; }
}

constexpr int BG_TILE_OFF = 69632, BG_TAB_OFF = BG_TILE_OFF + NWAVES * 8192, BG_MAXIT = 40;
static_assert(BG_TAB_OFF + NWAVES * BG_MAXIT * 32 <= LDSCTL_OFF, "bg table");
struct BgConv {
    Frame* F; unsigned ldsb; LAS float* tile; LAS unsigned* tab; int k, nit, inflight; unsigned char* dst; int pitch;
    __device__ __forceinline__ void init(Frame& Fr) { F = &Fr; tile = (LAS float*)(Fr.lds + RING_OFF + BG_TILE_OFF + Fr.wave * 8192); ldsb = (unsigned)(uintptr_t)tile;
        tab = (LAS unsigned*)(Fr.lds + RING_OFF + BG_TAB_OFF + Fr.wave * (BG_MAXIT * 32));
        const int first = P0_ITEMS_DENSE + Fr.vcu * NWAVES + Fr.wave, stride = Fr.G * NWAVES;
        nit = first < P0_ITEMS_ALL ? (P0_ITEMS_ALL - 1 - first) / stride + 1 : 0; if (nit > BG_MAXIT) nit = BG_MAXIT;
        if (Fr.lane < nit) { const P0Item d = p0_decode(Fr, first + Fr.lane * stride); LAS unsigned* e = tab + Fr.lane * 8;
            const unsigned long long sp = (unsigned long long)(uintptr_t)d.src, dp = (unsigned long long)(uintptr_t)d.dst;
            e[0] = (unsigned)sp; e[1] = (unsigned)(sp >> 32); e[2] = (unsigned)dp; e[3] = (unsigned)(dp >> 32); e[4] = (unsigned)d.ldw * 4u; e[5] = (unsigned)d.pitch; }
        LDS_WAIT(); asm volatile("" ::: "memory");
        k = 0; inflight = 0; dst = nullptr; pitch = 0; }
    __device__ __forceinline__ int issue_half(int half) {
        if (k >= nit) return 0;
        const LAS unsigned* e = tab + k * 8;
        const v4u e0 = *(const LAS v4u*)e; const v2u e1 = *(const LAS v2u*)(e + 4);
        const unsigned s0 = __builtin_amdgcn_readfirstlane(e0.x), s1 = __builtin_amdgcn_readfirstlane(e0.y), d0 = __builtin_amdgcn_readfirstlane(e0.z), d1 = __builtin_amdgcn_readfirstlane(e0.w);
        const unsigned ldwb = __builtin_amdgcn_readfirstlane(e1.x), pt = __builtin_amdgcn_readfirstlane(e1.y);
        unsigned long long sb = (((unsigned long long)s1 << 32) | s0) + (unsigned long long)ldwb * (half ? 32ull : 0ull);
        const unsigned rowoff = (unsigned)(F->lane >> 3) * ldwb, l16 = (unsigned)(F->lane & 7) * 16u;
        const unsigned lb = ldsb + (half ? 4096u : 0u), sw = half ? 64u : 0u;
#pragma unroll
        for (int i = 0; i < 4; ++i) { unsigned keep; const unsigned ld = (unsigned)__builtin_amdgcn_readfirstlane((int)(lb + i * 1024));
            const unsigned vo = rowoff + ((l16 - 32u * (i >> 1) - sw) & 112u);
            asm volatile("s_mov_b32 %0, m0\n\ts_mov_b32 m0, %3\n\ts_nop 0\n\tglobal_load_lds_dwordx4 %1, %2 nt\n\ts_mov_b32 m0, %0" : "=&s"(keep) : "v"(vo), "s"(sb), "s"(ld) : "memory");
            sb += (unsigned long long)ldwb * 8ull; }
        if (half) { dst = (unsigned char*)(uintptr_t)(((unsigned long long)d1 << 32) | d0); pitch = (int)pt; inflight = 1; ++k; }
        return 4;
    }
    __device__ __forceinline__ int issue() {
        if (k >= nit) return 0;
        const LAS unsigned* e = tab + k * 8;
        const v4u e0 = *(const LAS v4u*)e; const v2u e1 = *(const LAS v2u*)(e + 4);
        const unsigned s0 = __builtin_amdgcn_readfirstlane(e0.x), s1 = __builtin_amdgcn_readfirstlane(e0.y), d0 = __builtin_amdgcn_readfirstlane(e0.z), d1 = __builtin_amdgcn_readfirstlane(e0.w);
        const unsigned ldwb = __builtin_amdgcn_readfirstlane(e1.x), pt = __builtin_amdgcn_readfirstlane(e1.y);
        unsigned long long sb = ((unsigned long long)s1 << 32) | s0;
        const unsigned rowoff = (unsigned)(F->lane >> 3) * ldwb, l16 = (unsigned)(F->lane & 7) * 16u;
#pragma unroll
        for (int i = 0; i < 8; ++i) { unsigned keep; const unsigned ld = (unsigned)__builtin_amdgcn_readfirstlane((int)(ldsb + i * 1024));
            const unsigned vo = rowoff + ((l16 - 32u * (i >> 1)) & 112u);
            asm volatile("s_mov_b32 %0, m0\n\ts_mov_b32 m0, %3\n\ts_nop 0\n\tglobal_load_lds_dwordx4 %1, %2 nt\n\ts_mov_b32 m0, %0" : "=&s"(keep) : "v"(vo), "s"(sb), "s"(ld) : "memory");
            sb += (unsigned long long)ldwb * 8ull; }
        dst = (unsigned char*)(uintptr_t)(((unsigned long long)d1 << 32) | d0); pitch = (int)pt; inflight = 1; ++k; return 8;
    }
    __device__ __forceinline__ int process() {
        if (!inflight) return 0;
        const int lane = F->lane;
#pragma unroll
        for (int j = 0; j < 2; ++j) { const int id = lane + 64 * j, n = id >> 2, kc = id & 3; const LAS float* sp = tile + (16 * kc) * 32 + ((n + 8 * kc) & 31);
            v4u o;
            o.x = pg8::pk_fp8x4(sp[0 * 32] * pg8::WSCALE, sp[1 * 32] * pg8::WSCALE, sp[2 * 32] * pg8::WSCALE, sp[3 * 32] * pg8::WSCALE);
            o.y = pg8::pk_fp8x4(sp[4 * 32] * pg8::WSCALE, sp[5 * 32] * pg8::WSCALE, sp[6 * 32] * pg8::WSCALE, sp[7 * 32] * pg8::WSCALE);
            o.z = pg8::pk_fp8x4(sp[8 * 32] * pg8::WSCALE, sp[9 * 32] * pg8::WSCALE, sp[10 * 32] * pg8::WSCALE, sp[11 * 32] * pg8::WSCALE);
            o.w = pg8::pk_fp8x4(sp[12 * 32] * pg8::WSCALE, sp[13 * 32] * pg8::WSCALE, sp[14 * 32] * pg8::WSCALE, sp[15 * 32] * pg8::WSCALE);
            __builtin_nontemporal_store(o, (GAS v4u*)(dst + (size_t)n * pitch + 16 * kc)); asm volatile("" ::: "memory"); }
        LDS_WAIT(); asm volatile("" ::: "memory");
        inflight = 0; return 2;
    }
    __device__ __forceinline__ int step() { const int a = process(); return a + issue(); }
    __device__ __forceinline__ int stepB() { const int a = process(); return a + issue_half(0); }
    __device__ __forceinline__ void drain() { VM_WAIT(); process(); while (k < nit) { issue(); VM_WAIT(); process(); } }
};

__device__ __forceinline__ void p0_prologue(Frame& F) {
    const float* c_in = F.in[I_C]; const float* ada_w = F.in[I_ADAW]; const float* ada_b = F.in[I_ADAB];
    float* MOD = (float*)(F.ws + WS_MOD);
    {
        LAS float* sc = (LAS float*)F.lds; LAS float* red = sc + 8192;
        for (int i = F.tid; i < 8192; i += 512) sc[i] = silu(c_in[i]);
        __syncthreads();
        for (int cg = F.vcu; cg < 192; cg += F.G) {
            const int col = cg * 32 + (F.lane & 31), kp = F.lane >> 5;
            float a[8];
#pragma unroll
            for (int b = 0; b < 8; ++b) a[b] = 0.f;
#pragma unroll 4
            for (int i = 0; i < 64; ++i) { const int k = F.wave * 128 + 2 * i + kp; const float w = __builtin_nontemporal_load(ada_w + (size_t)k * 6144 + col);
#pragma unroll
                for (int b = 0; b < 8; ++b) a[b] += sc[b * 1024 + k] * w; }
#pragma unroll
            for (int b = 0; b < 8; ++b) a[b] += __shfl_xor(a[b], 32);
            if (F.lane < 32) {
#pragma unroll
                for (int b = 0; b < 8; ++b) red[(F.wave * 8 + b) * 32 + F.lane] = a[b]; }
            __syncthreads();
            if (F.tid < 256) { const int b = F.tid >> 5, cl = F.tid & 31; float s = ada_b[cg * 32 + cl];
#pragma unroll
                for (int w = 0; w < 8; ++w) s += red[(w * 8 + b) * 32 + cl];
                MOD[b * 6144 + cg * 32 + cl] = s; }
            __syncthreads();
        }
    }
    {
        float* TAB = (float*)(F.ws + WS_TAB); const float* relt = F.in[I_RELT];
        for (int idx = F.vcu * 512 + F.tid; idx < 4 * 4096; idx += F.G * 512) {
            const int h = idx >> 12, i = idx & 4095; float v = 0.f;
            if (i < 4095) { const int rel = i - 2047, n = rel < 0 ? -rel : rel, ret = rel > 0 ? 16 : 0; int bk;
                if (n < 8) bk = ret + n;
                else { int large = 8 + (int)(logf((float)n / 8.0f) / 2.772588722239781f * 8.0f); large = large < 15 ? large : 15; bk = ret + large; }
                v = relt[bk * 4 + h] * LOG2E; }
            TAB[idx] = v;
        }
        if (blockIdx.x == 0 && F.wave == 0) {
            const float s1 = wave_sum(F.in[I_LQ1][F.lane] * F.in[I_LK1][F.lane]), s2 = wave_sum(F.in[I_LQ2][F.lane] * F.in[I_LK2][F.lane]);
            if (F.lane == 0) ((float*)(F.ws + WS_LAM))[0] = expf(s1) - expf(s2) + 0.2f;
        }
    }
    __syncthreads();
    {
        LAS float* scr = (LAS float*)(F.lds + RING_OFF + F.wave * 16384);
        const int gw = F.vcu * NWAVES + F.wave, NGW = F.G * NWAVES;
        constexpr int NITEMS = P0_ITEMS_DENSE;
        if (gw < NITEMS) {
            P0Item d0 = p0_decode(F, gw), d1 = d0; float a[32], bq[32], cq[32];
            p0_load(d0, a, F.lane);
            if (gw + NGW < NITEMS) { d1 = p0_decode(F, gw + NGW); p0_load(d1, bq, F.lane); }
            for (int it = gw; it < NITEMS; it += NGW) {
                const int it2 = it + 2 * NGW; P0Item d2 = d1;
                if (it2 < NITEMS) { d2 = p0_decode(F, it2); p0_load(d2, cq, F.lane); }
                p0_store(d0, a, scr, F.lane);
                if (it + NGW >= NITEMS) break;
                d0 = d1; d1 = d2;
#pragma unroll
                for (int i = 0; i < 32; ++i) { a[i] = bq[i]; bq[i] = cq[i]; }
            }
        }
        for (int it = P0_ITEMS_DENSE + gw + BG_MAXIT * NGW; it < P0_ITEMS_ALL; it += NGW) { const P0Item d = p0_decode(F, it); float a[32]; p0_load(d, a, F.lane); p0_store(d, a, scr, F.lane); }
    }
}

__device__ __forceinline__ void p1_rows(Frame& F) {
    const float* x = F.in[I_X]; const float* gm = F.in[I_GMIX]; const float* MOD = (const float*)(F.ws + WS_MOD);
    bf16* XN = (bf16*)(F.ws + WS_XN);
    const int gw = F.vcu * NWAVES + F.wave, NGW = F.G * NWAVES;
    constexpr int R = 4;
    for (int m0 = gw * R; m0 < MTOK; m0 += NGW * R) {
        const int b = m0 >> 11;
        f32x4 v[R][4]; float ss[R];
#pragma unroll
        for (int r = 0; r < R; ++r) { const GAS f32x4* xr = (const GAS f32x4*)(x + (size_t)(m0 + r) * 1024) + F.lane;
#pragma unroll
            for (int j = 0; j < 4; ++j) v[r][j] = __builtin_nontemporal_load(xr + 64 * j); }
#pragma unroll
        for (int r = 0; r < R; ++r) { float t = 0.f;
#pragma unroll
            for (int j = 0; j < 4; ++j) t += (v[r][j].x * v[r][j].x + v[r][j].y * v[r][j].y) + (v[r][j].z * v[r][j].z + v[r][j].w * v[r][j].w);
            ss[r] = t; }
#pragma unroll
        for (int o = 1; o < 64; o <<= 1) {
#pragma unroll
            for (int r = 0; r < R; ++r) ss[r] += __shfl_xor(ss[r], o); }
#pragma unroll
        for (int r = 0; r < R; ++r) ss[r] = 1.0f / sqrtf(ss[r] * (1.f / 1024.f) + EPSN);
#pragma unroll
        for (int j = 0; j < 4; ++j) { const int col = 256 * j + 4 * F.lane;
            const f32x4 g = *(const f32x4*)(gm + col), sh = *(const f32x4*)(MOD + b * 6144 + col), sc = *(const f32x4*)(MOD + b * 6144 + 1024 + col);
#pragma unroll
            for (int r = 0; r < R; ++r) { const f32x4 h = (v[r][j] * ss[r] * g) * (sc + 1.0f) + sh;
                v2u o; o.x = pk2(h.x, h.y); o.y = pk2(h.z, h.w); ((GAS v2u*)(XN + (size_t)(m0 + r) * 1024) + F.lane)[64 * j] = o; } }
    }
}

#define MFMA16(a, b, c) __builtin_amdgcn_mfma_f32_16x16x32_bf16((a), (b), (c), 0, 0, 0)
constexpr int XTP = 136;
constexpr int SLP = 72;

__device__ __forceinline__ void ssd_a_unit(Frame& F, int b, int c, int g) {
    LAS bf16* XT = (LAS bf16*)F.lds;
    LAS bf16* BT = XT + 256 * XTP;
    LAS float* WF = (LAS float*)(BT + 64 * XTP);
    const bf16* P = (const bf16*)(F.ws + WS_P); bf16* XA = (bf16*)(F.ws + WS_XA);
    const float* convw = F.in[I_CONVW]; const float* convb = F.in[I_CONVB];
    const int row0 = b * SEQL + c * CHK, s0 = c * CHK;
    if (F.tid < 384) {
        const int cv = F.tid % 48, tg = F.tid / 48;
        const int ch = cv < 32 ? g * 256 + cv * 8 : (cv < 40 ? 512 + g * 64 + (cv - 32) * 8 : 640 + g * 64 + (cv - 40) * 8);
        float w[5][8], bb[8];
#pragma unroll
        for (int i = 0; i < 8; ++i) { bb[i] = convb[ch + i];
#pragma unroll
            for (int j = 0; j < 5; ++j) w[j][i] = convw[j * 768 + ch + i]; }
        LAS bf16* TT = cv < 32 ? XT + (cv * 8) * XTP : BT + ((cv - 32) * 8) * XTP;
#pragma unroll 1
        for (int pass = 0; pass < 2; ++pass) {
            const int t0 = 8 * (tg + 8 * pass);
            u16x8 rows[12];
#pragma unroll
            for (int i = 0; i < 12; ++i) { const int sq = s0 + t0 + i - 2;
                if (sq >= 0 && sq < SEQL) rows[i] = *(const u16x8*)(P + (size_t)(b * SEQL + sq) * NPC + XBCOFF + ch); else rows[i] = (u16x8){0, 0, 0, 0, 0, 0, 0, 0}; }
#pragma unroll
            for (int tt = 0; tt < 8; ++tt) {
                float a0[8];
                asm volatile("" : "+v"(rows[tt + 4]));
#pragma unroll
                for (int i = 0; i < 8; ++i) a0[i] = bb[i];
#pragma unroll
                for (int j = 0; j < 5; ++j)
#pragma unroll
                    for (int i = 0; i < 8; ++i) a0[i] += bf2f(rows[tt + j][i]) * w[j][i];
#pragma unroll
                for (int i = 0; i < 8; ++i) a0[i] = silu(a0[i]);
                v4u o; o.x = pk2(a0[0], a0[1]); o.y = pk2(a0[2], a0[3]); o.z = pk2(a0[4], a0[5]); o.w = pk2(a0[6], a0[7]);
                *(v4u*)(XA + (size_t)(row0 + t0 + tt) * 768 + ch) = o;
                if (cv < 40) {
#pragma unroll
                    for (int i = 0; i < 8; ++i) TT[i * XTP + t0 + tt] = (bf16)f2bf(a0[i]);
                }
            }
        }
    }
    {
        const int hh = F.wave & 3, dir = F.wave >> 2, h = g * 4 + hh;
        const float* DTRAW = (const float*)(F.ws + WS_DTRAW); float* DTV = (float*)(F.ws + WS_DTV); float* CS = (float*)(F.ws + WS_CS); float* TOT = (float*)(F.ws + WS_TOT);
        const float* pbias = dir ? F.in[I_DTBB] : F.in[I_DTBF]; const float* palog = dir ? F.in[I_ALOGB] : F.in[I_ALOGF];
        const float bias = pbias[h], A = -expf(palog[h]);
        float dt[2], av[2];
#pragma unroll
        for (int i = 0; i < 2; ++i) { const float xr = DTRAW[(size_t)(row0 + 2 * F.lane + i) * 16 + dir * 8 + h] + bias; dt[i] = xr > 20.f ? xr : log1pf(expf(xr)); av[i] = dt[i] * A; }
        float s = av[0] + av[1];
#pragma unroll
        for (int o = 1; o < 64; o <<= 1) { const float t = __shfl_up(s, o); if (F.lane >= o) s += t; }
        const float tot = __shfl(s, 63);
        float cs[2]; cs[1] = s; cs[0] = s - av[1];
#pragma unroll
        for (int i = 0; i < 2; ++i) { const int tl = 2 * F.lane + i; const size_t o = (size_t)(row0 + tl) * 16 + dir * 8 + h;
            const float cv = dir ? cs[i] - av[i] : cs[i];
            DTV[o] = dt[i]; CS[o] = cv;
            WF[(dir * 4 + hh) * 128 + tl] = (dir ? __expf(cv) : __expf(tot - cs[i])) * dt[i]; }
        if (F.lane == 0) TOT[(b * NCH + c) * 16 + dir * 8 + h] = tot;
    }
    __syncthreads();
    {
        const int hh = F.wave & 3, dir = F.wave >> 2, h = g * 4 + hh, l15 = F.lane & 15, lq = F.lane >> 4;
        f32x4 acc[4][4];
#pragma unroll
        for (int i = 0; i < 4; ++i)
#pragma unroll
            for (int j = 0; j < 4; ++j) acc[i][j] = (f32x4){0.f, 0.f, 0.f, 0.f};
#pragma unroll
        for (int ks = 0; ks < 4; ++ks) {
            const int k0 = 32 * ks + 8 * lq;
            const f32x4 w0 = *(const LAS f32x4*)(WF + (dir * 4 + hh) * 128 + k0), w1 = *(const LAS f32x4*)(WF + (dir * 4 + hh) * 128 + k0 + 4);
            bf16x8 af[4], bfr[4];
#pragma unroll
            for (int mt = 0; mt < 4; ++mt) af[mt] = *(const LAS bf16x8*)(XT + (hh * 64 + 16 * mt + l15) * XTP + k0);
#pragma unroll
            for (int nt = 0; nt < 4; ++nt) { const u16x8 raw = *(const LAS u16x8*)(BT + (16 * nt + l15) * XTP + k0);
                v4u pk; pk.x = pk2(bf2f(raw[0]) * w0.x, bf2f(raw[1]) * w0.y); pk.y = pk2(bf2f(raw[2]) * w0.z, bf2f(raw[3]) * w0.w);
                pk.z = pk2(bf2f(raw[4]) * w1.x, bf2f(raw[5]) * w1.y); pk.w = pk2(bf2f(raw[6]) * w1.z, bf2f(raw[7]) * w1.w);
                bfr[nt] = __builtin_bit_cast(bf16x8, pk); }
#pragma unroll
            for (int mt = 0; mt < 4; ++mt)
#pragma unroll
                for (int nt = 0; nt < 4; ++nt) acc[mt][nt] = MFMA16(af[mt], bfr[nt], acc[mt][nt]);
        }
        float* ST = (float*)(F.ws + WS_ST) + ((size_t)(((b * NCH + c) * 8 + h) * 2 + dir)) * 4096;
#pragma unroll
        for (int mt = 0; mt < 4; ++mt)
#pragma unroll
            for (int nt = 0; nt < 4; ++nt)
#pragma unroll
                for (int r = 0; r < 4; ++r) ST[(16 * mt + 4 * lq + r) * 64 + 16 * nt + l15] = acc[mt][nt][r];
    }
    __syncthreads();
}

__device__ __forceinline__ void ps_scan(Frame& F) {
    const float* ST = (const float*)(F.ws + WS_ST); const float* TOT = (const float*)(F.ws + WS_TOT); bf16* SIN = (bf16*)(F.ws + WS_SIN);
    for (int gt = F.vcu * 512 + F.tid; gt < 128 * 1024; gt += F.G * 512) {
        const int seq = gt >> 10, el = (gt & 1023) * 4, b = seq >> 4, h = (seq >> 1) & 7, dir = seq & 1;
        f32x4 st[16]; float et[16];
#pragma unroll
        for (int c = 0; c < 16; ++c) { st[c] = *(const f32x4*)(ST + ((size_t)(((b * NCH + c) * 8 + h) * 2 + dir)) * 4096 + el); et[c] = __expf(TOT[(b * NCH + c) * 16 + dir * 8 + h]); }
        f32x4 run = (f32x4){0.f, 0.f, 0.f, 0.f};
        if (dir == 0) {
#pragma unroll
            for (int c = 0; c < 16; ++c) { v2u o; o.x = pk2(run.x, run.y); o.y = pk2(run.z, run.w); *(v2u*)(SIN + ((size_t)(((b * NCH + c) * 8 + h) * 2 + dir)) * 4096 + el) = o; run = run * et[c] + st[c]; }
        } else {
#pragma unroll
            for (int c = 15; c >= 0; --c) { v2u o; o.x = pk2(run.x, run.y); o.y = pk2(run.z, run.w); *(v2u*)(SIN + ((size_t)(((b * NCH + c) * 8 + h) * 2 + dir)) * 4096 + el) = o; run = run * et[c] + st[c]; }
        }
    }
}

__device__ __forceinline__ void ssd_b_unit(Frame& F, int b, int c, int g, const XcdBarrier& wb, bool pend) {
    LAS bf16* XT2 = (LAS bf16*)F.lds;
    LAS bf16* SL = XT2 + 128 * XTP;
    LAS bf16* WL = SL + 4 * 64 * SLP;
    LAS float* AR = (LAS float*)(WL + 8 * 16 * XTP);
    const bf16* XA = (const bf16*)(F.ws + WS_XA); const bf16* P = (const bf16*)(F.ws + WS_P); bf16* AO = (bf16*)(F.ws + WS_AO);
    const float* DTV = (const float*)(F.ws + WS_DTV); const float* CS = (const float*)(F.ws + WS_CS); const float* TOT = (const float*)(F.ws + WS_TOT);
    const int row0 = b * SEQL + c * CHK, l15 = F.lane & 15, lq = F.lane >> 4, w = F.wave;
    bf16x8 cf[2];
#pragma unroll
    for (int ks = 0; ks < 2; ++ks) cf[ks] = *(const bf16x8*)(XA + (size_t)(row0 + 16 * w + l15) * 768 + 640 + g * 64 + 32 * ks + 8 * lq);
    f32x4 G[8];
#pragma unroll
    for (int j = 0; j < 8; ++j) { G[j] = (f32x4){0.f, 0.f, 0.f, 0.f};
#pragma unroll
        for (int ks = 0; ks < 2; ++ks) { const bf16x8 bfr = *(const bf16x8*)(XA + (size_t)(row0 + 16 * j + l15) * 768 + 512 + g * 64 + 32 * ks + 8 * lq); G[j] = MFMA16(cf[ks], bfr, G[j]); } }
    unsigned ygp[4][4][2];
    float ssq = 0.f;
#pragma unroll 1
    for (int hp = 0; hp < 2; ++hp) {
        __syncthreads();
        for (int v = F.tid; v < CHK * 16; v += 512) { const int tl = v >> 4, cv = v & 15;
            const u16x8 pv = *(const u16x8*)(XA + (size_t)(row0 + tl) * 768 + g * 256 + hp * 128 + cv * 8);
#pragma unroll
            for (int i = 0; i < 8; ++i) XT2[(cv * 8 + i) * XTP + tl] = pv[i]; }
        for (int v = F.tid; v < 1024; v += 512) { const int kind = v >> 8, hh2 = (v >> 7) & 1, tl = v & 127, h = g * 4 + hp * 2 + hh2;
            const size_t o = (size_t)(row0 + tl) * 16 + ((kind & 1) ? 8 : 0) + h;
            AR[v] = (kind < 2) ? CS[o] : DTV[o]; }
        if (pend) { xcd_wait(wb); pend = false; }
        { const int combo = F.tid >> 7, hh2 = combo & 1, dir = combo >> 1, h = g * 4 + hp * 2 + hh2, idx = (F.tid & 127) * 32, p = idx >> 6, n = idx & 63;
            const bf16* src = (const bf16*)(F.ws + WS_SIN) + ((size_t)(((b * NCH + c) * 8 + h) * 2 + dir)) * 4096 + idx;
            v4u t[4];
#pragma unroll
            for (int q = 0; q < 4; ++q) t[q] = *(const v4u*)(src + 8 * q);
#pragma unroll
            for (int q = 0; q < 4; ++q) *(LAS v4u*)(SL + (combo * 64 + p) * SLP + n + 8 * q) = t[q]; }
        __syncthreads();
#pragma unroll 1
        for (int hh2 = 0; hh2 < 2; ++hh2) {
            const int hd = hp * 2 + hh2, h = g * 4 + hd;
            const LAS float* csf = AR + (0 * 2 + hh2) * 128; const LAS float* ecsb = AR + (1 * 2 + hh2) * 128; const LAS float* dtf = AR + (2 * 2 + hh2) * 128; const LAS float* dtb = AR + (3 * 2 + hh2) * 128;
            v2u zq[4];
#pragma unroll
            for (int pt = 0; pt < 4; ++pt) zq[pt] = *(const v2u*)(P + (size_t)(row0 + 16 * w + l15) * NPC + ZOFF + h * 64 + 16 * pt + 4 * lq);
            const float totb = TOT[(b * NCH + c) * 16 + 8 + h], dsk = F.in[I_DSKIP][h];
            float csl[4], ecl[4];
#pragma unroll
            for (int r = 0; r < 4; ++r) { csl[r] = csf[16 * w + 4 * lq + r]; ecl[r] = ecsb[16 * w + 4 * lq + r]; }
            LAS bf16* wl = WL + w * 16 * XTP;
#pragma unroll
            for (int j = 0; j < 8; ++j) { const int s = 16 * j + l15; const float cs_s = csf[s], ec_s = ecsb[s], df = dtf[s], db = dtb[s];
#pragma unroll
                for (int r = 0; r < 4; ++r) { const int l = 16 * w + 4 * lq + r;
                    const float arg = (s < l) ? (csl[r] - cs_s) : (ec_s - ecl[r]); const float mul = (s < l) ? df : db;
                    float val = G[j][r] * __expf(arg) * mul; if (s == l) val = G[j][r] * (df + db);
                    wl[(4 * lq + r) * XTP + s] = (bf16)f2bf(val); } }
            LDS_WAIT(); asm volatile("" ::: "memory");
            f32x4 yd[4], yf[4], yb[4];
#pragma unroll
            for (int pt = 0; pt < 4; ++pt) { yd[pt] = (f32x4){0.f, 0.f, 0.f, 0.f}; yf[pt] = yd[pt]; yb[pt] = yd[pt]; }
#pragma unroll
            for (int ks = 0; ks < 4; ++ks) { const bf16x8 af = *(const LAS bf16x8*)(wl + l15 * XTP + 32 * ks + 8 * lq);
#pragma unroll
                for (int pt = 0; pt < 4; ++pt) { const bf16x8 bfr = *(const LAS bf16x8*)(XT2 + (hh2 * 64 + 16 * pt + l15) * XTP + 32 * ks + 8 * lq); yd[pt] = MFMA16(bfr, af, yd[pt]); } }
#pragma unroll
            for (int ks = 0; ks < 2; ++ks)
#pragma unroll
                for (int pt = 0; pt < 4; ++pt) {
                    const bf16x8 bf_ = *(const LAS bf16x8*)(SL + ((0 * 2 + hh2) * 64 + 16 * pt + l15) * SLP + 32 * ks + 8 * lq); yf[pt] = MFMA16(bf_, cf[ks], yf[pt]);
                    const bf16x8 bb_ = *(const LAS bf16x8*)(SL + ((1 * 2 + hh2) * 64 + 16 * pt + l15) * SLP + 32 * ks + 8 * lq); yb[pt] = MFMA16(bb_, cf[ks], yb[pt]); }
            float yt[4][4];
            { const int l = 16 * w + l15; const float ef = __expf(csf[l]), eb = __expf(totb - ecsb[l]);
#pragma unroll
                for (int pt = 0; pt < 4; ++pt) { const int p0 = 16 * pt + 4 * lq;
                    const v2u zz = zq[pt];
                    const float zf[4] = {__builtin_bit_cast(float, zz.x << 16), __builtin_bit_cast(float, zz.x & 0xffff0000u), __builtin_bit_cast(float, zz.y << 16), __builtin_bit_cast(float, zz.y & 0xffff0000u)};
#pragma unroll
                    for (int r = 0; r < 4; ++r) { const float xv = bf2f(XT2[(hh2 * 64 + p0 + r) * XTP + l]);
                        const float y = (yd[pt][r] + ef * yf[pt][r] + eb * yb[pt][r] + dsk * xv) * silu(zf[r]);
                        yt[pt][r] = y; ssq += y * y; } } }
            unsigned pk[4][2];
#pragma unroll
            for (int pt = 0; pt < 4; ++pt) { pk[pt][0] = pk2(yt[pt][0], yt[pt][1]); pk[pt][1] = pk2(yt[pt][2], yt[pt][3]); }
#define YG_COPY(HD) do { _Pragma("unroll") for (int pt = 0; pt < 4; ++pt) { ygp[HD][pt][0] = pk[pt][0]; ygp[HD][pt][1] = pk[pt][1]; } } while (0)
            if (hd == 0) YG_COPY(0); else if (hd == 1) YG_COPY(1); else if (hd == 2) YG_COPY(2); else YG_COPY(3);
#undef YG_COPY
        }
    }
    const float* ng = F.in[I_SSMG];
    ssq += __shfl_xor(ssq, 16); ssq += __shfl_xor(ssq, 32);
    { const float rstd = 1.0f / sqrtf(ssq * (1.f / 256.f) + EPSN); const int l = 16 * w + l15;
#pragma unroll
        for (int hd = 0; hd < 4; ++hd)
#pragma unroll
            for (int pt = 0; pt < 4; ++pt) { const int chn = g * 256 + hd * 64 + 16 * pt + 4 * lq; const f32x4 gg = *(const f32x4*)(ng + chn);
                const unsigned p01 = ygp[hd][pt][0], p23 = ygp[hd][pt][1];
                v2u o; o.x = pk2(__builtin_bit_cast(float, p01 << 16) * rstd * gg.x, __builtin_bit_cast(float, p01 & 0xffff0000u) * rstd * gg.y);
                o.y = pk2(__builtin_bit_cast(float, p23 << 16) * rstd * gg.z, __builtin_bit_cast(float, p23 & 0xffff0000u) * rstd * gg.w);
                *(v2u*)(AO + (size_t)(row0 + l) * 1024 + 512 + chn) = o; } }
    __syncthreads();
}

__device__ __forceinline__ void attn_finalize_rows(Frame& F) {
    const bf16* R0 = (const bf16*)(F.ws + WS_AORAW); const bf16* R1 = R0 + (size_t)MTOK * 512; bf16* AO = (bf16*)(F.ws + WS_AO);
    const float lam = ((const float*)(F.ws + WS_LAM))[0]; const float* sg = F.in[I_SUBLN];
    const int gw = F.vcu * NWAVES + F.wave, NGW = F.G * NWAVES;
    const int d0 = (F.lane & 15) * 8;
    float gv[8];
#pragma unroll
    for (int i = 0; i < 8; ++i) gv[i] = sg[d0 + i] * 0.8f;
    constexpr int R = 4;
    for (int m0 = gw * R; m0 < MTOK; m0 += NGW * R) {
        u16x8 a[R], bq[R];
#pragma unroll
        for (int r = 0; r < R; ++r) { a[r] = *(const u16x8*)(R0 + (size_t)(m0 + r) * 512 + F.lane * 8); bq[r] = *(const u16x8*)(R1 + (size_t)(m0 + r) * 512 + F.lane * 8); }
#pragma unroll
        for (int r = 0; r < R; ++r) {
            float d[8]; float ss = 0.f;
#pragma unroll
            for (int i = 0; i < 8; ++i) { d[i] = bf2f(a[r][i]) - lam * bf2f(bq[r][i]); ss += d[i] * d[i]; }
            ss += __shfl_xor(ss, 1); ss += __shfl_xor(ss, 2); ss += __shfl_xor(ss, 4); ss += __shfl_xor(ss, 8);
            const float rstd = 1.0f / sqrtf(ss * (1.f / 128.f) + EPSN);
            v4u o; o.x = pk2(d[0] * rstd * gv[0], d[1] * rstd * gv[1]); o.y = pk2(d[2] * rstd * gv[2], d[3] * rstd * gv[3]);
            o.z = pk2(d[4] * rstd * gv[4], d[5] * rstd * gv[5]); o.w = pk2(d[6] * rstd * gv[6], d[7] * rstd * gv[7]);
            *(v4u*)(AO + (size_t)(m0 + r) * 1024 + F.lane * 8) = o;
        }
    }
}

__device__ __forceinline__ void p6_fill(Frame& F) {
    LAS float* wT = (LAS float*)F.lds;
    const float* rw = F.in[I_ROUTW];
    { float tmp[32];
#pragma unroll
        for (int i = 0; i < 32; ++i) tmp[i] = rw[F.tid + 512 * i];
#pragma unroll
        for (int i = 0; i < 32; ++i) { const int idx = F.tid + 512 * i, k = idx >> 4, j = idx & 15; wT[j * 1024 + k] = tmp[i]; } }
}
__device__ __forceinline__ void p6_rows(Frame& F) {
    LAS float* wT = (LAS float*)F.lds;
    const bf16* x1 = (const bf16*)(F.ws + WS_X1); const float* gm = F.in[I_GFFN]; const float* MOD = (const float*)(F.ws + WS_MOD);
    unsigned char* H2 = F.ws + WS_H2; float* AFF = (float*)(F.ws + WS_AFF);
    const int gw = F.vcu * NWAVES + F.wave, NGW = F.G * NWAVES;
    constexpr int R = 4;
    for (int m0 = gw * R; m0 < MTOK; m0 += NGW * R) {
        const int b = m0 >> 11, t0 = m0 & 2047;
        f32x4 v[R][4]; float ss[R];
#pragma unroll
        for (int r = 0; r < R; ++r) { const GAS v2u* xr = (const GAS v2u*)(x1 + (size_t)(m0 + r) * 1024) + F.lane;
#pragma unroll
            for (int j = 0; j < 4; ++j) { const v2u y = __builtin_nontemporal_load(xr + 64 * j);
                v[r][j] = (f32x4){__builtin_bit_cast(float, y.x << 16), __builtin_bit_cast(float, y.x & 0xffff0000u), __builtin_bit_cast(float, y.y << 16), __builtin_bit_cast(float, y.y & 0xffff0000u)}; } }
#pragma unroll
        for (int r = 0; r < R; ++r) { float t = 0.f;
#pragma unroll
            for (int j = 0; j < 4; ++j) t += (v[r][j].x * v[r][j].x + v[r][j].y * v[r][j].y) + (v[r][j].z * v[r][j].z + v[r][j].w * v[r][j].w);
            ss[r] = t; }
#pragma unroll
        for (int o = 1; o < 64; o <<= 1) {
#pragma unroll
            for (int r = 0; r < R; ++r) ss[r] += __shfl_xor(ss[r], o); }
#pragma unroll
        for (int r = 0; r < R; ++r) ss[r] = 1.0f / sqrtf(ss[r] * (1.f / 1024.f) + EPSN);
#pragma unroll
        for (int j = 0; j < 4; ++j) { const int col = 256 * j + 4 * F.lane;
            const f32x4 g = *(const f32x4*)(gm + col), sh = *(const f32x4*)(MOD + b * 6144 + 3072 + col), sc = *(const f32x4*)(MOD + b * 6144 + 4096 + col);
#pragma unroll
            for (int r = 0; r < R; ++r) { v[r][j] = (v[r][j] * ss[r] * g) * (sc + 1.0f) + sh;
                ((GAS unsigned*)(H2 + (size_t)(m0 + r) * 1024) + F.lane)[64 * j] = pg8::pk_fp8x4(v[r][j].x, v[r][j].y, v[r][j].z, v[r][j].w); } }
#pragma unroll
        for (int r = 0; r < R; r += 2) {
            float p[16], q[16];
#pragma unroll
            for (int jj = 0; jj < 16; ++jj) { float t = 0.f, u = 0.f;
#pragma unroll
                for (int j = 0; j < 4; ++j) { const f32x4 w = *(const LAS f32x4*)(wT + jj * 1024 + 256 * j + 4 * F.lane);
                    t += (v[r][j].x * w.x + v[r][j].y * w.y) + (v[r][j].z * w.z + v[r][j].w * w.w); u += (v[r + 1][j].x * w.x + v[r + 1][j].y * w.y) + (v[r + 1][j].z * w.z + v[r + 1][j].w * w.w); }
                p[jj] = t; q[jj] = u; if ((jj & 3) == 3) asm volatile("" ::: "memory"); }
            const float lgs[2] = {reduce16(p, F.lane), reduce16(q, F.lane)};
#pragma unroll
            for (int rr = 0; rr < 2; ++rr) {
                const float lg = lgs[rr];
                float mx = lg;
                mx = fmaxf(mx, __shfl_xor(mx, 4)); mx = fmaxf(mx, __shfl_xor(mx, 8)); mx = fmaxf(mx, __shfl_xor(mx, 16)); mx = fmaxf(mx, __shfl_xor(mx, 32));
                const float ex = expf(lg - mx); float sm = ex;
                sm += __shfl_xor(sm, 4); sm += __shfl_xor(sm, 8); sm += __shfl_xor(sm, 16); sm += __shfl_xor(sm, 32);
                if ((F.lane & 3) == 0) AFF[((size_t)(b * NE + reduce16_index(F.lane))) * SEQL + t0 + r + rr] = ex / sm;
            }
        }
    }
}

__device__ __forceinline__ void topk_task(Frame& F, int pm) {
    const float* AFF = (const float*)(F.ws + WS_AFF); int* IDX = (int*)(F.ws + WS_IDX); float* GATE = (float*)(F.ws + WS_GATE); int* SLOT = (int*)(F.ws + WS_SLOT);
    const int b = pm & 7, e = pm >> 3, task = b * NE + e;
    unsigned v[32];
#pragma unroll
    for (int i = 0; i < 32; ++i) v[i] = __builtin_bit_cast(unsigned, AFF[(size_t)task * SEQL + i * 64 + F.lane]);
    unsigned T = 0u;
    for (int bit = 30; bit >= 0; --bit) { const unsigned cand = T | (1u << bit); int c = 0;
#pragma unroll
        for (int i = 0; i < 32; ++i) c += (v[i] >= cand) ? 1 : 0;
        int cnt = 0;
#pragma unroll
        for (int bb = 0; bb < 6; ++bb) cnt += __popcll(__ballot((c >> bb) & 1)) << bb;
        if (cnt >= CAP) T = cand; }
    int cgt = 0;
#pragma unroll
    for (int i = 0; i < 32; ++i) cgt += __popcll(__ballot(v[i] > T));
    const int need = CAP - cgt;
    const unsigned long long lt = (1ull << F.lane) - 1ull;
    int running = 0, eqrun = 0;
#pragma unroll
    for (int i = 0; i < 32; ++i) {
        const bool gt = v[i] > T, eq = v[i] == T;
        const unsigned long long eqm = __ballot(eq);
        const int eqrank = eqrun + __popcll(eqm & lt);
        const bool sel = gt || (eq && eqrank < need);
        const unsigned long long sm = __ballot(sel);
        const int slot = running + __popcll(sm & lt), t = i * 64 + F.lane;
        if (sel) { IDX[pm * CAP + slot] = b * SEQL + t; GATE[pm * CAP + slot] = __builtin_bit_cast(float, v[i]); }
        SLOT[(size_t)(b * SEQL + t) * NE + e] = sel ? pm * CAP + slot : -1;
        running += __popcll(sm); eqrun += __popcll(eqm);
    }
}
template <class Sched> __device__ __forceinline__ void topk_for_units(Frame& F, const Sched& S) {
    pg8::Unit u; int prev = -1, nt = 0;
    for (int i = 0; S.next(i, u); ++i) { if (u.pm != prev) { if ((nt & 7) == F.wave) topk_task(F, u.pm); prev = u.pm; ++nt; } }
    VM_WAIT(); __syncthreads();
}

__device__ __forceinline__ void p10_rows(Frame& F) {
    const bf16* x1 = (const bf16*)(F.ws + WS_X1); float* outp = F.out; const float* gf = F.in[I_GFIN]; const float* MOD = (const float*)(F.ws + WS_MOD);
    const unsigned char* Y = F.ws + WS_Y; const int* SLOT = (const int*)(F.ws + WS_SLOT);
    const int gw = F.vcu * NWAVES + F.wave, NGW = F.G * NWAVES;
    constexpr int R = 2;
    int sln[R]; v2u xn[R][4];
#define P10_FETCH(M0) do { _Pragma("unroll") for (int r = 0; r < R; ++r) { sln[r] = SLOT[(size_t)((M0) + r) * NE + (F.lane & 15)]; const GAS v2u* xr = (const GAS v2u*)(x1 + (size_t)((M0) + r) * 1024) + F.lane; \
        _Pragma("unroll") for (int j = 0; j < 4; ++j) xn[r][j] = __builtin_nontemporal_load(xr + 64 * j); } } while (0)
    if (gw * R < MTOK) P10_FETCH(gw * R);
    for (int m0 = gw * R; m0 < MTOK; m0 += NGW * R) {
        const int b = m0 >> 11;
        int sl[R]; unsigned mk[R]; v2u xc[R][4];
#pragma unroll
        for (int r = 0; r < R; ++r) { sl[r] = sln[r];
#pragma unroll
            for (int j = 0; j < 4; ++j) xc[r][j] = xn[r][j]; }
        f32x4 v[R][4], a[R][4];
#pragma unroll
        for (int r = 0; r < R; ++r) mk[r] = (unsigned)__ballot(sl[r] >= 0) & 0xffffu;
        unsigned y[R][4][4]; float wq[R][4];
#pragma unroll
        for (int r = 0; r < R; ++r)
#pragma unroll
            for (int q = 0; q < 4; ++q) { const bool has = mk[r] != 0u; const int e = has ? __builtin_ctz(mk[r]) : 0; mk[r] &= mk[r] - 1u;
                const int srow = has ? __builtin_amdgcn_readlane(sl[r], e) : 0; wq[r][q] = has ? pg8::WSCALE_INV : 0.f; if (!has) mk[r] = 0u;
                const GAS unsigned* yr = (const GAS unsigned*)(Y + (size_t)srow * 1024) + F.lane;
#pragma unroll
                for (int j = 0; j < 4; ++j) y[r][q][j] = __builtin_nontemporal_load(yr + 64 * j); }
        asm volatile("" ::: "memory");
        if (m0 + NGW * R < MTOK) P10_FETCH(m0 + NGW * R);
#pragma unroll
        for (int r = 0; r < R; ++r)
#pragma unroll
            for (int j = 0; j < 4; ++j) { const v2u y0 = xc[r][j];
                v[r][j] = (f32x4){__builtin_bit_cast(float, y0.x << 16), __builtin_bit_cast(float, y0.x & 0xffff0000u), __builtin_bit_cast(float, y0.y << 16), __builtin_bit_cast(float, y0.y & 0xffff0000u)};
                a[r][j] = (f32x4){0.f, 0.f, 0.f, 0.f}; }
#pragma unroll
        for (int r = 0; r < R; ++r)
#pragma unroll
            for (int q = 0; q < 4; ++q)
#pragma unroll
                for (int j = 0; j < 4; ++j) { const unsigned yy = y[r][q][j]; const float w = wq[r][q];
                    const auto lo = __builtin_amdgcn_cvt_pk_f32_fp8((int)yy, false), hi = __builtin_amdgcn_cvt_pk_f32_fp8((int)yy, true);
                    a[r][j].x += w * lo[0]; a[r][j].y += w * lo[1]; a[r][j].z += w * hi[0]; a[r][j].w += w * hi[1]; }
#pragma unroll
        for (int r = 0; r < R; ++r) while (mk[r] != 0u) { const int e = __builtin_ctz(mk[r]); mk[r] &= mk[r] - 1u; const int srow = __builtin_amdgcn_readlane(sl[r], e);
            const GAS unsigned* yr = (const GAS unsigned*)(Y + (size_t)srow * 1024) + F.lane;
#pragma unroll
            for (int j = 0; j < 4; ++j) { const unsigned yy = yr[64 * j];
                const auto lo = __builtin_amdgcn_cvt_pk_f32_fp8((int)yy, false), hi = __builtin_amdgcn_cvt_pk_f32_fp8((int)yy, true);
                a[r][j].x += pg8::WSCALE_INV * lo[0]; a[r][j].y += pg8::WSCALE_INV * lo[1]; a[r][j].z += pg8::WSCALE_INV * hi[0]; a[r][j].w += pg8::WSCALE_INV * hi[1]; } }
        float ss[R];
#pragma unroll
        for (int r = 0; r < R; ++r) ss[r] = 0.f;
#pragma unroll
        for (int j = 0; j < 4; ++j) { const int col = 256 * j + 4 * F.lane; const f32x4 g2 = *(const f32x4*)(MOD + b * 6144 + 5120 + col);
#pragma unroll
            for (int r = 0; r < R; ++r) { v[r][j] = v[r][j] + g2 * a[r][j]; ss[r] += (v[r][j].x * v[r][j].x + v[r][j].y * v[r][j].y) + (v[r][j].z * v[r][j].z + v[r][j].w * v[r][j].w); } }
#pragma unroll
        for (int o = 1; o < 64; o <<= 1) {
#pragma unroll
            for (int r = 0; r < R; ++r) ss[r] += __shfl_xor(ss[r], o); }
#pragma unroll
        for (int j = 0; j < 4; ++j) { const int col = 256 * j + 4 * F.lane; const f32x4 g = *(const f32x4*)(gf + col);
#pragma unroll
            for (int r = 0; r < R; ++r) { const float rstd = 1.0f / sqrtf(ss[r] * (1.f / 1024.f) + EPSN); __builtin_nontemporal_store(v[r][j] * rstd * g, (GAS f32x4*)(outp + (size_t)(m0 + r) * 1024) + F.lane + 64 * j); } }
    }
}

struct Args { const float* in[27]; float* out; unsigned char* ws; int ph_lo, ph_hi; };
__global__ void __launch_bounds__(NWAVES * 64, 2) mk_fwd(Args args) {
    extern __shared__ __attribute__((aligned(16))) unsigned char lds[];
    Frame F;
    F.lds = (LAS unsigned char*)lds;
    F.MISC = (volatile LAS unsigned*)(F.lds + MISC_OFF);
    F.tid = threadIdx.x; F.lane = F.tid & 63; F.wave = __builtin_amdgcn_readfirstlane(F.tid >> 6);
    F.G = gridDim.x; { const int bx = blockIdx.x; F.vcu = (F.G % 8 == 0) ? (bx % 8) * (F.G / 8) + bx / 8 : bx; }
#pragma unroll
    for (int i = 0; i < 27; ++i) F.in[i] = args.in[i];
    F.out = args.out; F.ws = args.ws; F.ctl = (gu32*)(args.ws + WS_CTL);
    for (int u = F.tid; u < (LDS_BYTES - LDSCTL_OFF) / 4; u += NWAVES * 64) ((LAS unsigned*)(F.lds + LDSCTL_OFF))[u] = 0u;
    __syncthreads();
    XcdBarrier bar; bar.bar = (unsigned*)(F.ctl + CW_BAR); bar.x = 0; bar.st = nullptr;
    if (N_LAUNCHES != PER_PHASE) bar = xcd_barrier_post((unsigned*)(F.ctl + CW_BAR), F.MISC + 8);
    const int lo = args.ph_lo, hi = args.ph_hi;
#ifndef PH_MASK
#define PH_MASK 0x7ff
#endif
#define IN(k) (((PH_MASK >> (k)) & 1) && lo <= (k) && (k) < hi)
#define SEAM(k) do { if (IN(k) && IN((k) + 1)) xcd_barrier(bar); } while (0)

    BgConv bg;
    if (IN(0)) { p0_prologue(F); SEAM(0); }
    if (IN(1)) { p1_rows(F); SEAM(1); }
    if (IN(2)) {
        pg8::Gemm g{F.ws + WS_XN, F.ws + WS_WIN, 2048}; pg8::StaticOrder S; S.init(MTOK, 3072, F.G, (int)blockIdx.x);
        pg8::EpiP E{(bf16*)(F.ws + WS_P), NPC, 2, 0.125f * LOG2E, (float*)(F.ws + WS_DTRAW)}; pg8::ARowDense AR;
        pg8::gemm_phase<pg8::EpiP, pg8::StaticOrder, pg8::ARowDense, true, false>(F.lds + RING_OFF, g, S, E, AR);
        if (IN(3)) { xcd_arrive(bar); bg.init(F); xcd_wait(bar); }
    }
    if (IN(3)) {
        const float* TAB = (const float*)(F.ws + WS_TAB);
        const attn2::bf16* P = (const attn2::bf16*)(F.ws + WS_P); attn2::bf16* AORAW = (attn2::bf16*)(F.ws + WS_AORAW);
#ifndef NO_ATTN
        if (!IN(2)) bg.init(F);
        int hprev = -1; float clo = 0.f, chi = 0.f;
        __syncthreads();
        for (int u = F.vcu; u < 512; u += F.G) {
            const int bhm = u >> 3, qb = u & 7, b = bhm >> 3, h = (bhm >> 1) & 3, mp = bhm & 1;
            const float* tabsrc = nullptr;
            if (h != hprev) {
                tabsrc = TAB + h * 4096 - 256 + 2047; hprev = h;
                clo = __builtin_bit_cast(float, __builtin_amdgcn_readfirstlane(__builtin_bit_cast(int, TAB[h * 4096]))); chi = __builtin_bit_cast(float, __builtin_amdgcn_readfirstlane(__builtin_bit_cast(int, TAB[h * 4096 + 4094]))); }
            const size_t rowb = (size_t)b * SEQL;
            attn2::attn_unit(P + (rowb + qb * 256) * NPC + QOFF + h * 128 + mp * 64, P + rowb * NPC + KOFF + h * 128 + mp * 64, P + rowb * NPC + VOFF + h * 128,
                             AORAW + (size_t)mp * MTOK * 512 + (rowb + qb * 256) * 512 + h * 128, qb, (char*)lds + RING_OFF, tabsrc, clo, chi, bg);
        }
        bg.drain();
#endif
        __syncthreads();
#ifndef NO_SSDA
        for (int u = F.vcu; u < 256; u += F.G) ssd_a_unit(F, u >> 5, (u >> 1) & 15, u & 1);
#endif
        SEAM(3);
    }
    if (IN(4)) { ps_scan(F); attn_finalize_rows(F); if (IN(5)) xcd_arrive(bar); }
    if (IN(5)) {
        { bool pend = IN(4); for (int u = F.vcu; u < 256; u += F.G) { ssd_b_unit(F, u >> 5, (u >> 1) & 15, u & 1, bar, pend); pend = false; } if (pend) xcd_wait(bar); }
        SEAM(5);
    }
    if (IN(6)) {
        pg8::Gemm g{F.ws + WS_AO, F.ws + WS_WOUT, 2048}; pg8::StaticOrder S; S.init(MTOK, 1024, F.G, (int)blockIdx.x);
        pg8::EpiX1 E{F.in[I_X], (bf16*)(F.ws + WS_X1), (const float*)(F.ws + WS_MOD)}; pg8::ARowDense AR;
        pg8::gemm_phase<pg8::EpiX1, pg8::StaticOrder, pg8::ARowDense, true, false>(F.lds + RING_OFF, g, S, E, AR);
        if (IN(7)) { xcd_arrive(bar); p6_fill(F); xcd_wait(bar); }
    }
    if (IN(7)) { if (!IN(6)) { p6_fill(F); __syncthreads(); } p6_rows(F); SEAM(7); }
    if (IN(8)) {
        pg8::Gemm g{F.ws + WS_H2, F.ws + WS_WGU, 1024}; pg8::MoeOrder<22> S{F.G, F.vcu};
        pg8::EpiHid E{F.ws + WS_HID}; pg8::ARowGather AR{(const int*)(F.ws + WS_IDX)};
        topk_for_units(F, S);
        pg8::gemm_phase<pg8::EpiHid, pg8::MoeOrder<22>, pg8::ARowGather, true, true>(F.lds + RING_OFF, g, S, E, AR);
        SEAM(8);
    }
    if (IN(9)) {
        pg8::Gemm g{F.ws + WS_HID, F.ws + WS_WD, FFD}; pg8::MoeOrder<4> S{F.G, F.vcu};
        pg8::EpiY E{F.ws + WS_Y, (const float*)(F.ws + WS_GATE)}; pg8::ARowDenseVO AR;
        pg8::gemm_phase<pg8::EpiY, pg8::MoeOrder<4>, pg8::ARowDenseVO, true, true>(F.lds + RING_OFF, g, S, E, AR);
        SEAM(9);
    }
    if (IN(10)) { p10_rows(F); }
#undef IN
#undef SEAM
}

extern "C" void kernel_launch(void* const* d_in, const int* in_sizes, int n_in, void* d_out, int out_size, void* d_ws, size_t ws_size, hipStream_t stream) {
    static int grid = 0;
    if (grid == 0) {
        if (n_in != 27 || in_sizes[0] != MTOK * DMODEL || out_size != MTOK * DMODEL || ws_size < WS_END) {
            fprintf(stderr, "kernel_launch: unexpected shapes: n_in %d, in0 %d, out %d, ws %zu (need %zu); nothing launched\n", n_in, n_in > 0 ? in_sizes[0] : -1, out_size, ws_size, (size_t)WS_END); grid = -1; return; }
        int dev = 0, cus = 0, per_cu = 0;
        if (hipGetDevice(&dev) != hipSuccess || hipDeviceGetAttribute(&cus, hipDeviceAttributeMultiprocessorCount, dev) != hipSuccess) { grid = -1; return; }
        if (hipFuncSetAttribute((const void*)mk_fwd, hipFuncAttributeMaxDynamicSharedMemorySize, LDS_BYTES) != hipSuccess) { fprintf(stderr, "kernel_launch: hipFuncSetAttribute failed\n"); grid = -1; return; }
        if (hipOccupancyMaxActiveBlocksPerMultiprocessor(&per_cu, (const void*)mk_fwd, NWAVES * 64, LDS_BYTES) != hipSuccess || per_cu < 1) { fprintf(stderr, "kernel_launch: occupancy query says %d\n", per_cu); per_cu = 1; }
        (void)hipGetLastError();
        grid = cus;
        if (grid > 256) grid = 256;
    }
    if (grid < 0) return;
    (void)hipMemsetAsync((char*)d_ws + WS_CTL, 0, CTL_ZERO_BYTES, stream);
    Args a{};
    for (int i = 0; i < 27; ++i) a.in[i] = (const float*)d_in[i];
    a.out = (float*)d_out; a.ws = (unsigned char*)d_ws;
    if (N_LAUNCHES == 1) { a.ph_lo = 0; a.ph_hi = PER_PHASE; hipLaunchKernelGGL(mk_fwd, dim3(grid), dim3(NWAVES * 64), LDS_BYTES, stream, a); }
    else { for (int li = 0; li < PER_PHASE; ++li) { a.ph_lo = li; a.ph_hi = li + 1; hipLaunchKernelGGL(mk_fwd, dim3(grid), dim3(NWAVES * 64), LDS_BYTES, stream, a); } }
}
```

```cpp
#include <hip/hip_runtime.h>
#include <hip/hip_bf16.h>
#include <cstdio>
#include <cstdint>
#include <cmath>

#ifndef MK_N_LAUNCHES
#define MK_N_LAUNCHES 1
#endif

namespace pg8 {
#define PG8_LAS __attribute__((address_space(3)))
typedef unsigned short bf16_t;
typedef short bf16x8 __attribute__((ext_vector_type(8)));
typedef float f32x4 __attribute__((ext_vector_type(4)));
typedef unsigned u32x4 __attribute__((ext_vector_type(4)));
constexpr int BM = 256, BK = 64, HALF = 128, HTB = HALF * BK * 2  , STAGE_BYTES = 8 * HTB, NXCD = 8, WGM = 8;

__host__ __device__ __forceinline__ int lds_byte(int r, int c) { const int st = (r >> 4) * 2 + (c >> 5), rr = r & 15, cc = c & 31, ob = rr * 64 + cc * 2; return st * 1024 + (ob ^ (((ob >> 9) & 1) << 5)); }
__host__ __device__ __forceinline__ void stage_rc(int b, int& R, int& C) { const int st = b / 1024, sb = b % 1024, swz = sb ^ (((sb >> 9) & 1) << 5); R = (st >> 1) * 16 + swz / 64; C = (st & 1) * 32 + (swz % 64) / 2; }
__host__ __device__ __forceinline__ int perm32(int rho) { const int n = rho >> 4, i = rho & 15; return 8 * (i >> 2) + 4 * n + (i & 3); }

struct Unit { int pm, pn; };
struct Gemm { const void* A; const void* Bt; int KB; };

struct StaticOrder {
    int nM, nN, nwg, G, c;
    __host__ __device__ void init(int M, int N, int G_, int c_) { nM = M / BM; nN = N / BM; nwg = nM * nN; G = G_; c = c_; }
    __host__ __device__ bool next(int i, Unit& u) const {
        const long L = (long)i * G + c; if (L >= nwg) return false;
        int wgid = (int)L; { const int q = nwg / NXCD, r = nwg % NXCD, xcd = wgid % NXCD, off = wgid / NXCD; wgid = (xcd < r ? xcd * (q + 1) : r * (q + 1) + (xcd - r) * q) + off; }
        const int nig = WGM * nN, gid = wgid / nig, fm = gid * WGM, gsz = (nM - fm) < WGM ? (nM - fm) : WGM;
        u.pm = fm + ((wgid % nig) % gsz); u.pn = (wgid % nig) / gsz; return true;
    }
};
template <int NJ> struct MoeOrder {
    int G, v;
    __device__ bool next(int i, Unit& u) const {
        if (G == 256) {
            const int x = v >> 5, s = v & 31, b = s & 7, q = s >> 3, gi = 4 * i + q;
            if (gi >= 2 * NJ) return false;
            const int e = 2 * x + gi / NJ, j = gi % NJ; u.pm = e * 8 + b; u.pn = e * NJ + j; return true;
        } else {
            const long L = (long)i * G + v; if (L >= 16L * NJ * 8) return false;
            const int b = (int)(L & 7), gi = (int)(L >> 3), e = gi / NJ, j = gi % NJ; u.pm = e * 8 + b; u.pn = e * NJ + j; return true;
        }
    }
};
struct ARowDense { static constexpr bool GATHER = false; __device__ __forceinline__ unsigned row(const Unit& u, int r) const { return (unsigned)(u.pm * BM + r); } };
struct ARowDenseVO { static constexpr bool GATHER = true; __device__ __forceinline__ unsigned row(const Unit& u, int r) const { return (unsigned)(u.pm * BM + r); } };
struct ARowGather { static constexpr bool GATHER = true; const int* idx; __device__ __forceinline__ unsigned row(const Unit& u, int r) const { return (unsigned)idx[u.pm * BM + r]; } };

__device__ __forceinline__ unsigned cvt_pk_bf16(float lo, float hi) { unsigned r; asm volatile("v_cvt_pk_bf16_f32 %0, %1, %2" : "=v"(r) : "v"(lo), "v"(hi)); return r; }

struct EpiP {
    static constexpr bool PERM = true;
    bf16_t* O; int ldc; int nscale; float scale0; float* dtraw;
    __device__ __forceinline__ void operator()(const f32x4 (&acc)[2][2][4][2], const Unit& u, int wr, int wc, int fr, int fq) const {
        const int row0 = u.pm * BM + wr * 64 + fr, col0 = u.pn * BM + wc * 32 + 8 * fq;
        if (u.pn == 11) {
            if (wc == 0 && fq < 2) {
#pragma unroll
                for (int ai = 0; ai < 2; ++ai)
#pragma unroll
                    for (int m = 0; m < 4; ++m) { float* dp = dtraw + (size_t)(row0 + ai * HALF + m * 16) * 16 + 8 * fq; *(f32x4*)dp = acc[ai][0][m][0]; *(f32x4*)(dp + 4) = acc[ai][0][m][1]; } }
            return; }
        const float sc = (u.pn < nscale) ? scale0 : 1.f;
#pragma unroll
        for (int ai = 0; ai < 2; ++ai)
#pragma unroll
            for (int m = 0; m < 4; ++m) { bf16_t* rowp = O + (size_t)(row0 + ai * HALF + m * 16) * ldc + col0;
#pragma unroll
                for (int bj = 0; bj < 2; ++bj) { const f32x4 v0 = acc[ai][bj][m][0] * sc, v1 = acc[ai][bj][m][1] * sc;
                    u32x4 w; w.x = cvt_pk_bf16(v0[0], v0[1]); w.y = cvt_pk_bf16(v0[2], v0[3]); w.z = cvt_pk_bf16(v1[0], v1[1]); w.w = cvt_pk_bf16(v1[2], v1[3]);
                    *(u32x4*)(rowp + bj * HALF) = w; } }
    }
};
struct EpiX1 {
    static constexpr bool PERM = true;
    const float* x; bf16_t* out; const float* mod;
    __device__ __forceinline__ void operator()(const f32x4 (&acc)[2][2][4][2], const Unit& u, int wr, int wc, int fr, int fq) const {
        const int row0 = u.pm * BM + wr * 64 + fr, col0 = u.pn * BM + wc * 32 + 8 * fq;
        const float* g1 = mod + (size_t)((u.pm * BM) >> 11) * 6144 + 2048;
        f32x4 gv[2][2];
#pragma unroll
        for (int bj = 0; bj < 2; ++bj)
#pragma unroll
            for (int n = 0; n < 2; ++n) gv[bj][n] = *(const f32x4*)(g1 + col0 + bj * HALF + n * 4);
#pragma unroll
        for (int ai = 0; ai < 2; ++ai)
#pragma unroll
            for (int m = 0; m < 4; ++m) { const size_t off = (size_t)(row0 + ai * HALF + m * 16) * 1024 + col0;
#pragma unroll
                for (int bj = 0; bj < 2; ++bj) { const f32x4 x0 = __builtin_nontemporal_load((const f32x4*)(x + off + bj * HALF)), x1v = __builtin_nontemporal_load((const f32x4*)(x + off + bj * HALF + 4));
                    const f32x4 v0 = x0 + gv[bj][0] * acc[ai][bj][m][0], v1 = x1v + gv[bj][1] * acc[ai][bj][m][1];
                    u32x4 w; w.x = cvt_pk_bf16(v0[0], v0[1]); w.y = cvt_pk_bf16(v0[2], v0[3]); w.z = cvt_pk_bf16(v1[0], v1[1]); w.w = cvt_pk_bf16(v1[2], v1[3]);
                    *(u32x4*)(out + off + bj * HALF) = w; } }
    }
};
__device__ __forceinline__ float silu_f(float v) { return v * __builtin_amdgcn_rcpf(1.f + __builtin_amdgcn_exp2f(-1.4426950408889634f * v)); }
typedef unsigned u32x2 __attribute__((ext_vector_type(2)));
__device__ __forceinline__ unsigned pk_fp8x4(float a, float b, float c, float d) { unsigned w = 0u; w = __builtin_amdgcn_cvt_pk_fp8_f32(a, b, w, false); w = __builtin_amdgcn_cvt_pk_fp8_f32(c, d, w, true); return w; }
constexpr float WSCALE = 64.f, WSCALE_INV = 1.f / 64.f;
struct EpiHid {
    static constexpr bool PERM = true;
    unsigned char* O;
    __device__ __forceinline__ void operator()(const f32x4 (&acc)[2][2][4][2], const Unit& u, int wr, int wc, int fr, int fq) const {
        const int row0 = u.pm * BM + wr * 64 + fr, col0 = (u.pn % 22) * HALF + wc * 32 + 8 * fq;
#pragma unroll
        for (int ai = 0; ai < 2; ++ai)
#pragma unroll
            for (int m = 0; m < 4; ++m) { unsigned char* rowp = O + (size_t)(row0 + ai * HALF + m * 16) * 2816 + col0;
                f32x4 h0, h1;
#pragma unroll
                for (int i = 0; i < 4; ++i) { h0[i] = silu_f(acc[ai][0][m][0][i] * WSCALE_INV) * (acc[ai][1][m][0][i] * WSCALE_INV); h1[i] = silu_f(acc[ai][0][m][1][i] * WSCALE_INV) * (acc[ai][1][m][1][i] * WSCALE_INV); }
                u32x2 w; w.x = pk_fp8x4(h0[0], h0[1], h0[2], h0[3]); w.y = pk_fp8x4(h1[0], h1[1], h1[2], h1[3]);
                *(u32x2*)rowp = w; }
    }
};
struct EpiY {
    static constexpr bool PERM = true;
    unsigned char* O; const float* gate;
    __device__ __forceinline__ void operator()(const f32x4 (&acc)[2][2][4][2], const Unit& u, int wr, int wc, int fr, int fq) const {
        const int row0 = u.pm * BM + wr * 64 + fr, col0 = (u.pn & 3) * BM + wc * 32 + 8 * fq;
#pragma unroll
        for (int ai = 0; ai < 2; ++ai)
#pragma unroll
            for (int m = 0; m < 4; ++m) { const int row = row0 + ai * HALF + m * 16; const float gt = gate[row]; unsigned char* rowp = O + (size_t)row * 1024 + col0;
#pragma unroll
                for (int bj = 0; bj < 2; ++bj) { const f32x4 v0 = acc[ai][bj][m][0] * gt, v1 = acc[ai][bj][m][1] * gt;
                    u32x2 w; w.x = pk_fp8x4(v0[0], v0[1], v0[2], v0[3]); w.y = pk_fp8x4(v1[0], v1[1], v1[2], v1[3]);
                    *(u32x2*)(rowp + bj * HALF) = w; }
                asm volatile("" ::: "memory"); }
    }
};

typedef int v4i_t __attribute__((ext_vector_type(4)));
typedef int v8i_t __attribute__((ext_vector_type(8)));
template <bool FP8> struct FragT;
template <> struct FragT<false> { struct A4 { bf16x8 v[4][2]; }; struct B2 { bf16x8 v[2][2]; }; };
template <> struct FragT<true>  { struct A4 { v8i_t v[4]; };    struct B2 { v8i_t v[2]; }; };
template <class Epi, class Sched, class ARow, bool ALIGN_EPI, bool FP8>
__device__ __forceinline__ void gemm_phase(PG8_LAS unsigned char* lds, const Gemm g, const Sched& S, const Epi& E, const ARow& AR) {
    constexpr bool GATHER = ARow::GATHER;
    const int tid = threadIdx.x, wid = __builtin_amdgcn_readfirstlane(tid >> 6), lane = tid & 63, wr = wid >> 2, wc = wid & 3, fr = lane & 15, fq = lane >> 4;
    const int KB = g.KB, nt = KB / 128;
    int pR[2], pC[2]; unsigned voffA[2], voffB[2];
#pragma unroll
    for (int i = 0; i < 2; ++i) { int R, C; stage_rc(tid * 16 + i * 8192, R, C); const int Rb = Epi::PERM ? ((R & ~31) + perm32(R & 31)) : R;
        pR[i] = R; pC[i] = C; voffA[i] = (unsigned)(R * KB + C * 2); voffB[i] = (unsigned)(Rb * KB + C * 2); }
    const size_t kstep = (size_t)(BK * 2);
    const size_t hstep = (size_t)HALF * KB;
    const size_t tstep = 2 * hstep;
    const unsigned ldsw = (unsigned)wid * 1024u;
    const int aoff = lds_byte(wr * 64 + fr, fq * 8), boff = lds_byte(wc * 32 + fr, fq * 8);
#define PG8_SA(b, h) (((b) * 2 + (h)) * HTB)
#define PG8_SB(b, h) ((4 + (b) * 2 + (h)) * HTB)
#define PG8_STAGE(bufoff, gbase, voff) do { _Pragma("unroll") for (int _i = 0; _i < 2; ++_i) \
        __builtin_amdgcn_global_load_lds((const unsigned*)((const char*)(gbase) + (voff)[_i]), (PG8_LAS unsigned*)(lds + (bufoff) + ldsw + _i * 8192), 16, 0, 0); } while (0)
#define PG8_STAGE_A(bufoff, kp, h) do { if constexpr (GATHER) { _Pragma("unroll") for (int _i = 0; _i < 2; ++_i) \
        __builtin_amdgcn_global_load_lds((const unsigned*)((const char*)(kp) + voAc[h][_i]), (PG8_LAS unsigned*)(lds + (bufoff) + ldsw + _i * 8192), 16, 0, 0); } \
        else { PG8_STAGE(bufoff, (kp) + (h) * hstep, voffA); } } while (0)
#define PG8_LD16(off) (*(const PG8_LAS v4i_t*)(lds + (off)))
#define PG8_LDA(dst, b, h) do { _Pragma("unroll") for (int m = 0; m < 4; ++m) { \
        if constexpr (FP8) { dst.v[m] = __builtin_shufflevector(PG8_LD16(PG8_SA(b, h) + aoff + m * 2048), PG8_LD16(PG8_SA(b, h) + aoff + m * 2048 + 1024), 0, 1, 2, 3, 4, 5, 6, 7); } \
        else { _Pragma("unroll") for (int k = 0; k < 2; ++k) dst.v[m][k] = *(const PG8_LAS bf16x8*)(lds + PG8_SA(b, h) + aoff + m * 2048 + k * 1024); } } } while (0)
#define PG8_LDB(dst, b, h) do { _Pragma("unroll") for (int n = 0; n < 2; ++n) { \
        if constexpr (FP8) { dst.v[n] = __builtin_shufflevector(PG8_LD16(PG8_SB(b, h) + boff + n * 2048), PG8_LD16(PG8_SB(b, h) + boff + n * 2048 + 1024), 0, 1, 2, 3, 4, 5, 6, 7); } \
        else { _Pragma("unroll") for (int k = 0; k < 2; ++k) dst.v[n][k] = *(const PG8_LAS bf16x8*)(lds + PG8_SB(b, h) + boff + n * 2048 + k * 1024); } } } while (0)
#define PG8_MMA(ai, bj, At, Bt) do { __builtin_amdgcn_s_setprio(1); _Pragma("unroll") for (int m = 0; m < 4; ++m) _Pragma("unroll") for (int n = 0; n < 2; ++n) { \
        if constexpr (FP8) { acc[ai][bj][m][n] = __builtin_amdgcn_mfma_scale_f32_16x16x128_f8f6f4(Bt.v[n], At.v[m], acc[ai][bj][m][n], 0, 0, 0, 0x7f7f7f7f, 0, 0x7f7f7f7f); } \
        else { _Pragma("unroll") for (int k = 0; k < 2; ++k) acc[ai][bj][m][n] = __builtin_amdgcn_mfma_f32_16x16x32_bf16(Bt.v[n][k], At.v[m][k], acc[ai][bj][m][n], 0, 0, 0); } } \
        __builtin_amdgcn_s_setprio(0); } while (0)
#define PG8_WAIT_V(n) asm volatile("s_waitcnt vmcnt(" #n ")" ::: "memory")
#define PG8_WAIT_L(n) asm volatile("s_waitcnt lgkmcnt(" #n ")" ::: "memory")
#define PG8_BAR __builtin_amdgcn_s_barrier()
#define PG8_SCHED __builtin_amdgcn_sched_barrier(0)
#define PG8_VOA(dst, u) do { _Pragma("unroll") for (int _h = 0; _h < 2; ++_h) _Pragma("unroll") for (int _i = 0; _i < 2; ++_i) \
        dst[_h][_i] = AR.row(u, _h * HALF + pR[_i]) * (unsigned)KB + (unsigned)pC[_i] * 2u; } while (0)
    Unit cur, nxt; int ui = 0;
    if (!S.next(0, cur)) return;
    f32x4 acc[2][2][4][2];
#pragma unroll
    for (int a = 0; a < 2; ++a)
#pragma unroll
        for (int b = 0; b < 2; ++b)
#pragma unroll
            for (int m = 0; m < 4; ++m)
#pragma unroll
                for (int n = 0; n < 2; ++n) acc[a][b][m][n] = (f32x4){0.f, 0.f, 0.f, 0.f};
    typedef typename FragT<FP8>::A4 FragA; typedef typename FragT<FP8>::B2 FragB;
    FragA At; FragB B0, B1;
    unsigned voAc[2][2], voAn[2][2];
    if constexpr (GATHER) { PG8_VOA(voAc, cur); }
    const char* cA = GATHER ? (const char*)g.A : (const char*)g.A + (size_t)cur.pm * tstep;
    const char* cB = (const char*)g.Bt + (size_t)cur.pn * tstep;
    PG8_STAGE(PG8_SB(0, 0), cB, voffB); PG8_STAGE(PG8_SB(0, 1), cB + hstep, voffB); PG8_STAGE_A(PG8_SA(0, 0), cA, 0); PG8_STAGE_A(PG8_SA(0, 1), cA, 1);
    if (wr == 1) PG8_BAR;
    PG8_WAIT_V(2); PG8_BAR;
    PG8_STAGE(PG8_SB(1, 0), cB + kstep, voffB); PG8_STAGE(PG8_SB(1, 1), cB + hstep + kstep, voffB); PG8_STAGE_A(PG8_SA(1, 0), cA + kstep, 0);
    PG8_WAIT_V(6); PG8_BAR;
    for (;;) {
        const bool has_next = S.next(ui + 1, nxt);
        if constexpr (GATHER) {
            if (has_next && nxt.pm != cur.pm) { PG8_VOA(voAn, nxt); }
            else {
#pragma unroll
                for (int h = 0; h < 2; ++h)
#pragma unroll
                    for (int i = 0; i < 2; ++i) voAn[h][i] = voAc[h][i]; }
        }
        const char* nA = (!GATHER && has_next) ? (const char*)g.A + (size_t)nxt.pm * tstep : cA;
        const char* nB = has_next ? (const char*)g.Bt + (size_t)nxt.pn * tstep : cB;
#pragma unroll 1
        for (int t = 0; t < nt; t += 2) {
            const bool last = (t == nt - 2);
            const char* a1 = cA + (size_t)(t + 1) * kstep;
            const char* a2 = last ? nA : cA + (size_t)(t + 2) * kstep; const char* b2 = last ? nB : cB + (size_t)(t + 2) * kstep;
            const char* a3 = a2 + kstep; const char* b3 = b2 + kstep;
            PG8_LDB(B0, 0, 0); PG8_LDB(B1, 0, 1); PG8_SCHED; PG8_LDA(At, 0, 0); PG8_STAGE_A(PG8_SA(1, 1), a1, 1);
            if constexpr (GATHER) { if (last) {
#pragma unroll
                for (int h = 0; h < 2; ++h)
#pragma unroll
                    for (int i = 0; i < 2; ++i) voAc[h][i] = voAn[h][i]; } }
            PG8_WAIT_V(8); PG8_WAIT_L(0); PG8_BAR; PG8_MMA(0, 0, At, B0); PG8_MMA(0, 1, At, B1); PG8_BAR; PG8_SCHED;
            PG8_LDA(At, 0, 1); PG8_STAGE(PG8_SB(0, 0), b2, voffB); PG8_STAGE(PG8_SB(0, 1), b2 + hstep, voffB);
            PG8_WAIT_V(6); PG8_WAIT_L(0); PG8_BAR; PG8_MMA(1, 0, At, B0); PG8_SCHED; PG8_STAGE_A(PG8_SA(0, 0), a2, 0); PG8_SCHED; PG8_MMA(1, 1, At, B1); PG8_BAR; PG8_SCHED;
            PG8_LDB(B0, 1, 0); PG8_LDB(B1, 1, 1); PG8_SCHED; PG8_LDA(At, 1, 0); PG8_STAGE_A(PG8_SA(0, 1), a2, 1);
            PG8_WAIT_V(8); PG8_WAIT_L(0); PG8_BAR; PG8_MMA(0, 0, At, B0); PG8_MMA(0, 1, At, B1); PG8_BAR; PG8_SCHED;
            PG8_LDA(At, 1, 1); PG8_STAGE(PG8_SB(1, 0), b3, voffB); PG8_STAGE(PG8_SB(1, 1), b3 + hstep, voffB);
            PG8_WAIT_V(6); PG8_WAIT_L(0); PG8_BAR; PG8_MMA(1, 0, At, B0); PG8_SCHED; PG8_STAGE_A(PG8_SA(1, 0), a3, 0); PG8_SCHED; PG8_MMA(1, 1, At, B1); PG8_BAR; PG8_SCHED;
        }
        if constexpr (ALIGN_EPI) { if (wr == 0) PG8_BAR; }
        E(acc, cur, wr, wc, fr, fq);
        if (!has_next) break;
#pragma unroll
        for (int a = 0; a < 2; ++a)
#pragma unroll
            for (int b = 0; b < 2; ++b)
#pragma unroll
                for (int m = 0; m < 4; ++m)
#pragma unroll
                    for (int n = 0; n < 2; ++n) acc[a][b][m][n] = (f32x4){0.f, 0.f, 0.f, 0.f};
        cur = nxt; cA = nA; cB = nB; ++ui;
        if constexpr (ALIGN_EPI) { if (wr == 1) PG8_BAR; }
    }
    PG8_WAIT_V(0);
    if constexpr (!ALIGN_EPI) { if (wr == 0) PG8_BAR; }
    PG8_BAR;
#undef PG8_SA
#undef PG8_SB
#undef PG8_STAGE
#undef PG8_STAGE_A
#undef PG8_LDA
#undef PG8_LDB
#undef PG8_MMA
#undef PG8_LD16
#undef PG8_WAIT_V
#undef PG8_WAIT_L
#undef PG8_BAR
#undef PG8_SCHED
#undef PG8_VOA
}
}

namespace attn2 {
using bf16 = __hip_bfloat16;
using bf16x8 = __attribute__((ext_vector_type(8))) short;
using s16x4  = __attribute__((ext_vector_type(4))) short;
using f32x16 = __attribute__((ext_vector_type(16))) float;
using u32x4  = __attribute__((ext_vector_type(4))) unsigned;
constexpr int NW = 8, QBLK = 32, KVBLK = 64, SEQ = 2048, LDP = 2816, LDO = 512;
constexpr float THRL = 11.5f;
constexpr int SHM_V = KVBLK * 128 * 2, SHM_K = KVBLK * 64 * 2;
constexpr int LDS_WS = 2 * SHM_V + 2 * SHM_K, LDS_TAB = LDS_WS + NW * 64 * 4, LDS_BYTES = LDS_TAB + 16384;
#define KSWZ64(row, colB) ((row) * 128 + ((colB) ^ ((((row) >> 1) & 7) << 4)))
#define SBAR() __builtin_amdgcn_sched_barrier(0)
typedef __attribute__((address_space(3))) const float* lds_fptr;
__device__ __forceinline__ int crow(int r, int hi) { return (r & 3) + 8 * (r >> 2) + 4 * hi; }
__device__ __forceinline__ unsigned cvtpk(float lo, float hi) { unsigned r; asm volatile("v_cvt_pk_bf16_f32 %0, %1, %2" : "=v"(r) : "v"(lo), "v"(hi)); return r; }
__device__ __forceinline__ float add_bias(f32x16& p0, f32x16& p1, int t, int qw0, int qabs, int hi, lds_fptr tab, float clo, float chi) {
  const int relmin = 64 * t - (qw0 + 31), relmax = 64 * t + 63 - qw0;
  if (relmax <= -128 || relmin >= 128) return relmin >= 128 ? chi : clo;
  const lds_fptr tp = tab + (64 * t - qabs + 256 + 4 * hi);
#pragma unroll
  for (int r = 0; r < 16; ++r) { const int o = (r & 3) + 8 * (r >> 2); p0[r] += tp[o]; p1[r] += tp[o + 32]; }
  return 0.f;
}
__device__ __forceinline__ void partialSM(f32x16& p0, f32x16& p1, float cb, float& m_reg, float& alpha) {
  float pmax = p0[0];
#pragma unroll
  for (int r = 1; r < 16; ++r) pmax = fmaxf(pmax, p0[r]);
#pragma unroll
  for (int r = 0; r < 16; ++r) pmax = fmaxf(pmax, p1[r]);
  { auto rr = __builtin_amdgcn_permlane32_swap(__float_as_uint(pmax), __float_as_uint(pmax), false, false);
    pmax = fmaxf(__uint_as_float(rr[0]), __uint_as_float(rr[1])) + cb; }
  float mn;
  if (__builtin_expect(__all(pmax - m_reg <= THRL), 1)) { mn = m_reg; alpha = 1.f; }
  else { mn = fmaxf(m_reg, pmax); alpha = __builtin_amdgcn_exp2f(m_reg - mn); m_reg = mn; }
  const float sub = mn - cb;
#pragma unroll
  for (int r = 0; r < 16; ++r) { p0[r] -= sub; p1[r] -= sub; }
#pragma unroll
  for (int r = 0; r < 16; ++r) p0[r] = __builtin_amdgcn_exp2f(p0[r]);
}
__device__ __forceinline__ void finishSM(f32x16& p0, f32x16& p1, float alpha, float& l_reg, bf16x8& pa0, bf16x8& pa1, bf16x8& pa2, bf16x8& pa3) {
#pragma unroll
  for (int r = 0; r < 16; ++r) p1[r] = __builtin_amdgcn_exp2f(p1[r]);
  float ps = 0;
#pragma unroll
  for (int r = 0; r < 16; ++r) ps += p0[r];
#pragma unroll
  for (int r = 0; r < 16; ++r) ps += p1[r];
  { auto rr = __builtin_amdgcn_permlane32_swap(__float_as_uint(ps), __float_as_uint(ps), false, false);
    ps = __uint_as_float(rr[0]) + __uint_as_float(rr[1]); }
  l_reg = l_reg * alpha + ps;
#define PK4(P, BASE, OUT) do { unsigned a0 = cvtpk(P[BASE + 0], P[BASE + 1]), a1 = cvtpk(P[BASE + 2], P[BASE + 3]);   \
    unsigned b0 = cvtpk(P[BASE + 4], P[BASE + 5]), b1 = cvtpk(P[BASE + 6], P[BASE + 7]);                              \
    auto r0 = __builtin_amdgcn_permlane32_swap(a0, b0, false, false); auto r1 = __builtin_amdgcn_permlane32_swap(a1, b1, false, false); \
    u32x4 w = {r0[0], r1[0], r0[1], r1[1]}; OUT = *reinterpret_cast<bf16x8*>(&w); } while (0)
  PK4(p0, 0, pa0); PK4(p0, 8, pa1); PK4(p1, 0, pa2); PK4(p1, 8, pa3);
#undef PK4
}
__device__ __forceinline__ void qkt(f32x16& p0, f32x16& p1, const bf16* Ks, const bf16x8* qr, int r32, int hi) {
  p0 = f32x16{}; p1 = f32x16{};
#pragma unroll
  for (int d0 = 0; d0 < 4; ++d0) { const int cb = (d0 * 16 + hi * 8) * 2;
    bf16x8 b0 = *reinterpret_cast<const bf16x8*>((const char*)Ks + KSWZ64(r32, cb));
    bf16x8 b1 = *reinterpret_cast<const bf16x8*>((const char*)Ks + KSWZ64(32 + r32, cb));
    p0 = __builtin_amdgcn_mfma_f32_32x32x16_bf16(b0, qr[d0], p0, 0, 0, 0);
    p1 = __builtin_amdgcn_mfma_f32_32x32x16_bf16(b1, qr[d0], p1, 0, 0, 0); }
}
__device__ __forceinline__ int v_st(int k, int c) { const int kk = (k & ~0xC) | ((k & 4) << 1) | ((k & 8) >> 1); return ((kk >> 3) * 4 + (c >> 5)) * 512 + ((kk & 7) * 32 + (c & 31)) * 2; }
__device__ __forceinline__ int v_rd_base(int lane) { return ((lane & 3) << 3) | (((lane >> 2) & 3) << 6) | (((lane >> 4) & 1) << 5) | (((lane >> 5) & 1) << 8); }
constexpr int v_rd_off(int d0, int ks, int half) { return d0 * 512 + ks * 4096 + half * 2048; }
template <int OFF> __device__ __forceinline__ s16x4 tr_read(int vb) {
  s16x4 r; asm volatile("ds_read_b64_tr_b16 %0, %1 offset:%2" : "=&v"(r) : "v"(vb), "i"(OFF) : "memory"); return r;
}
template <int D0> __device__ __forceinline__ void pv_one(f32x16& od, int vb, bf16x8 pa0, bf16x8 pa1, bf16x8 pa2, bf16x8 pa3) {
  const s16x4 l0 = tr_read<v_rd_off(D0, 0, 0)>(vb), h0 = tr_read<v_rd_off(D0, 0, 1)>(vb), l1 = tr_read<v_rd_off(D0, 1, 0)>(vb), h1 = tr_read<v_rd_off(D0, 1, 1)>(vb);
  const s16x4 l2 = tr_read<v_rd_off(D0, 2, 0)>(vb), h2 = tr_read<v_rd_off(D0, 2, 1)>(vb), l3 = tr_read<v_rd_off(D0, 3, 0)>(vb), h3 = tr_read<v_rd_off(D0, 3, 1)>(vb);
  asm volatile("s_waitcnt lgkmcnt(0)" ::: "memory"); SBAR();
#define PK(L, H) (bf16x8){L[0], L[1], L[2], L[3], H[0], H[1], H[2], H[3]}
  od = __builtin_amdgcn_mfma_f32_32x32x16_bf16(pa0, PK(l0, h0), od, 0, 0, 0);
  od = __builtin_amdgcn_mfma_f32_32x32x16_bf16(pa1, PK(l1, h1), od, 0, 0, 0);
  od = __builtin_amdgcn_mfma_f32_32x32x16_bf16(pa2, PK(l2, h2), od, 0, 0, 0);
  od = __builtin_amdgcn_mfma_f32_32x32x16_bf16(pa3, PK(l3, h3), od, 0, 0, 0);
#undef PK
}
__device__ __forceinline__ void pv_d0(f32x16* o, int vb, bf16x8 pa0, bf16x8 pa1, bf16x8 pa2, bf16x8 pa3) {
  pv_one<0>(o[0], vb, pa0, pa1, pa2, pa3); pv_one<1>(o[1], vb, pa0, pa1, pa2, pa3); pv_one<2>(o[2], vb, pa0, pa1, pa2, pa3); pv_one<3>(o[3], vb, pa0, pa1, pa2, pa3);
}
template <class Hook>
__device__ __forceinline__ void attn_unit(const bf16* __restrict__ Qb, const bf16* __restrict__ Kh, const bf16* __restrict__ Vh, bf16* __restrict__ Ob, int qb, char* lds, const float* tabsrc, float clo, float chi, Hook& hk) {
  const int tid = threadIdx.x, wid = __builtin_amdgcn_readfirstlane(tid >> 6), lane = tid & 63, r32 = lane & 31, hi = lane >> 5;
  bf16* V_lds = (bf16*)lds; bf16* K_lds = (bf16*)(lds + 2 * SHM_V);
  float* ws = (float*)(lds + LDS_WS) + wid * 64; float* li_l = ws; float* al_l = ws + 32;
  const lds_fptr tab = (lds_fptr)((__attribute__((address_space(3))) const char*)lds + LDS_TAB);
  float m_reg = -1e30f, l_reg = 0; f32x16 o[4] = {}; bf16x8 qr[4];
  const bf16* Qw = Qb + (long)(wid * QBLK + r32) * LDP + hi * 8;
#pragma unroll
  for (int d0 = 0; d0 < 4; ++d0) qr[d0] = *reinterpret_cast<const bf16x8*>(Qw + d0 * 16);
  const int qw0 = qb * 256 + wid * QBLK, qabs = qw0 + r32;
  const int kr = tid >> 3, kc = (tid & 7) * 8, kst = KSWZ64(kr, kc * 2);
  const int sr = tid >> 4, sc = (tid & 15) * 8, vst0 = v_st(sr, sc), vst1 = v_st(32 + sr, sc);
  const int vb0 = (int)(uintptr_t)V_lds + v_rd_base(lane);
  struct { bf16x8 vs0, vs1, ks0; } sr_[2];
  const unsigned voV = (unsigned)((sr * LDP + sc) * 2), voK = (unsigned)((kr * LDP + kc) * 2);
#define GLD16(d, vo, sb) asm volatile("global_load_dwordx4 %0, %1, %2" : "=v"(d) : "v"(vo), "s"(sb) : "memory")
#define SLOAD(i, k0) do { const bf16* vt_ = Vh + (long)(k0) * LDP; GLD16(sr_[i].vs0, voV, vt_); GLD16(sr_[i].vs1, voV, vt_ + 32 * LDP); GLD16(sr_[i].ks0, voK, Kh + (long)(k0) * LDP); } while (0)
#define FWAIT(nh) do { if ((nh) == 6) asm volatile("s_waitcnt vmcnt(9)" ::: "memory"); else if ((nh) == 4) asm volatile("s_waitcnt vmcnt(7)" ::: "memory"); \
    else if ((nh) == 2) asm volatile("s_waitcnt vmcnt(5)" ::: "memory"); else asm volatile("s_waitcnt vmcnt(3)" ::: "memory"); } while (0)
#define SWRITE(b, i) do { *(bf16x8*)((char*)V_lds + (b) * SHM_V + vst0) = sr_[i].vs0; *(bf16x8*)((char*)V_lds + (b) * SHM_V + vst1) = sr_[i].vs1; \
    *(bf16x8*)((char*)K_lds + (b) * SHM_K + kst) = sr_[i].ks0; } while (0)
#define SWAIT() asm volatile("s_waitcnt vmcnt(3)" ::: "memory")
#define ABAR() asm volatile("s_waitcnt lgkmcnt(0)\n\ts_barrier" ::: "memory")
#define RESC(a) do { if (__any((a) < 1.f)) { if (hi == 0) al_l[r32] = (a); asm volatile("s_waitcnt lgkmcnt(0)" ::: "memory"); \
    _Pragma("unroll") for (int d = 0; d < 4; ++d) _Pragma("unroll") for (int r = 0; r < 16; ++r) o[d][r] *= al_l[crow(r, hi)]; } } while (0)
  f32x16 pA0, pA1, pB0, pB1; float alA, alB; bf16x8 pa0, pa1, pa2, pa3; constexpr int NT = SEQ / KVBLK;
  constexpr int SE = 0, SO = 1;
  SLOAD(SE, 0); SLOAD(SO, KVBLK);
  if (tabsrc) ((float*)(lds + LDS_TAB))[tid] = tabsrc[tid];
  asm volatile("s_waitcnt vmcnt(0)" ::: "memory"); SWRITE(0, SE); SWRITE(1, SO); ABAR();
  SLOAD(SE, 2 * KVBLK);
  asm volatile("" ::: "memory"); int nh = hk.stepB();
  qkt(pA0, pA1, K_lds, qr, r32, hi); { const float cb = add_bias(pA0, pA1, 0, qw0, qabs, hi, tab, clo, chi); partialSM(pA0, pA1, cb, m_reg, alA); }
  for (int j = 1; j + 1 < NT; j += 2) {
    SBAR(); qkt(pB0, pB1, (bf16*)((char*)K_lds + SHM_K), qr, r32, hi);
    finishSM(pA0, pA1, alA, l_reg, pa0, pa1, pa2, pa3); SBAR();
    SLOAD(SO, (j + 2) * KVBLK); SBAR();
    pv_d0(o, vb0, pa0, pa1, pa2, pa3); { const float cb = add_bias(pB0, pB1, j, qw0, qabs, hi, tab, clo, chi); partialSM(pB0, pB1, cb, m_reg, alB); }
    ABAR(); FWAIT(nh); SWRITE(0, SE);
    asm volatile("" ::: "memory"); hk.issue_half(1);
    RESC(alB); ABAR();
    SBAR(); qkt(pA0, pA1, K_lds, qr, r32, hi);
    finishSM(pB0, pB1, alB, l_reg, pa0, pa1, pa2, pa3); SBAR();
    SLOAD(SE, (j + 3 < NT ? j + 3 : NT - 1) * KVBLK); SBAR();
    pv_d0(o, vb0 + (int)SHM_V, pa0, pa1, pa2, pa3); { const float cb = add_bias(pA0, pA1, j + 1, qw0, qabs, hi, tab, clo, chi); partialSM(pA0, pA1, cb, m_reg, alA); }
    ABAR(); SWAIT(); SWRITE(1, SO);
    asm volatile("" ::: "memory"); nh = hk.stepB();
    RESC(alA); ABAR();
  }
  asm volatile("" ::: "memory"); hk.issue_half(1);
  SBAR(); qkt(pB0, pB1, (bf16*)((char*)K_lds + SHM_K), qr, r32, hi);
  finishSM(pA0, pA1, alA, l_reg, pa0, pa1, pa2, pa3); SBAR();
  pv_d0(o, vb0, pa0, pa1, pa2, pa3); { const float cb = add_bias(pB0, pB1, NT - 1, qw0, qabs, hi, tab, clo, chi); partialSM(pB0, pB1, cb, m_reg, alB); }
  ABAR(); RESC(alB);
  finishSM(pB0, pB1, alB, l_reg, pa0, pa1, pa2, pa3); SBAR();
  pv_d0(o, vb0 + (int)SHM_V, pa0, pa1, pa2, pa3);
  if (hi == 0) li_l[r32] = l_reg; asm volatile("s_waitcnt lgkmcnt(0)" ::: "memory");
  float rli[16];
#pragma unroll
  for (int r = 0; r < 16; ++r) rli[r] = __builtin_amdgcn_rcpf(li_l[crow(r, hi)]);
  bf16* Ow = Ob + (long)(wid * QBLK) * LDO;
#pragma unroll
  for (int r = 0; r < 16; ++r) { const int orow = crow(r, hi);
#pragma unroll
    for (int d0 = 0; d0 < 4; ++d0) Ow[(long)orow * LDO + d0 * 32 + r32] = __float2bfloat16(o[d0][r] * rli[r]); }
  ABAR();
#undef SLOAD
#undef GLD16
#undef FWAIT
#undef SWRITE
#undef SWAIT
#undef RESC
#undef ABAR
}
#undef SBAR
#undef KSWZ64
}

constexpr int NWAVES = 8;
constexpr int N_LAUNCHES = MK_N_LAUNCHES;
constexpr int PER_PHASE = 11;
constexpr int NB = 8, SEQL = 2048, DMODEL = 1024, MTOK = NB * SEQL;
constexpr int NPC = 2816, NINC = 2832;
constexpr int QOFF = 0, KOFF = 512, VOFF = 1024, ZOFF = 1536, XBCOFF = 2048;
constexpr int NE = 16, CAP = 256, FFD = 2816;
constexpr int NCH = 16, CHK = 128;
constexpr float EPSN = 1e-6f;
constexpr float LOG2E = 1.4426950408889634f;

constexpr size_t MiB = 1u << 20;
constexpr size_t WS_CTL = 0, CTL_ZERO_BYTES = 64 * 1024;
constexpr size_t WS_MOD = 1 * MiB;
constexpr size_t WS_TAB = 1 * MiB + 256 * 1024;
constexpr size_t WS_LAM = 1 * MiB + 512 * 1024;
constexpr size_t WS_DUMMY = 1 * MiB + 768 * 1024;
constexpr size_t WS_TOT = 1 * MiB + 576 * 1024;
constexpr size_t WS_WIN = 2 * MiB, WS_WOUT = 8 * MiB, WS_WGU = 10 * MiB, WS_WD = 186 * MiB;
constexpr size_t WS_H2 = 274 * MiB;
constexpr size_t WS_SIN = 290 * MiB;
constexpr size_t WS_Y = 306 * MiB;
constexpr size_t WS_ST = 306 * MiB;
constexpr size_t WS_AORAW = 338 * MiB;
constexpr size_t WS_HID = 370 * MiB;
constexpr size_t WS_P = 370 * MiB;
constexpr size_t WS_XN = 458 * MiB;
constexpr size_t WS_X1 = 458 * MiB;
constexpr size_t WS_AO = 490 * MiB;
constexpr size_t WS_XA = 522 * MiB;
constexpr size_t WS_DTRAW = 546 * MiB, WS_DTV = 547 * MiB, WS_CS = 548 * MiB, WS_AFF = 549 * MiB;
constexpr size_t WS_IDX = 550 * MiB, WS_GATE = 550 * MiB + 512 * 1024, WS_SLOT = 551 * MiB, WS_END = 552 * MiB;
constexpr int CW_BAR = 4096;

constexpr int RING_OFF = 0, RING_BYTES = 131072;
constexpr int LDSCTL_OFF = 146432, MISC_OFF = LDSCTL_OFF + 320;
constexpr int LDS_BYTES = 147456;

#define GAS __attribute__((address_space(1)))
#define LAS __attribute__((address_space(3)))
typedef unsigned short bf16;
typedef unsigned v4u __attribute__((ext_vector_type(4)));
typedef unsigned v2u __attribute__((ext_vector_type(2)));
typedef float f32x4 __attribute__((ext_vector_type(4)));
typedef short bf16x8 __attribute__((ext_vector_type(8)));
typedef unsigned short u16x8 __attribute__((ext_vector_type(8)));
typedef GAS unsigned gu32;
#define RLX_AGENT __ATOMIC_RELAXED, __HIP_MEMORY_SCOPE_AGENT
#define LDS_WAIT() asm volatile("s_waitcnt lgkmcnt(0)" ::: "memory")
#define VM_WAIT() asm volatile("s_waitcnt vmcnt(0)" ::: "memory")
__device__ __forceinline__ unsigned f2bf(float f) { unsigned u = __builtin_bit_cast(unsigned, f); return (u + 0x7fffu + ((u >> 16) & 1u)) >> 16; }
__device__ __forceinline__ unsigned pk2(float lo, float hi) { return f2bf(lo) | (f2bf(hi) << 16); }
__device__ __forceinline__ float bf2f(unsigned short h) { return __builtin_bit_cast(float, (unsigned)h << 16); }
__device__ __forceinline__ float silu(float v) { return v / (1.f + __expf(-v)); }

#define XB_TMO      128
#define XB_XCNT(j)  (256  + 64 * (j))
#define XB_XSUB(j)  (1280 + 64 * (j))
#define XB_XGEN(j)  (2304 + 64 * (j))
#define XB_TOP      3328
#define XB_TOPGEN   3392
#define XCD_BAR_WORDS 3456
#define XB_SPIN_CAP (1u << 18)

__device__ __forceinline__ unsigned xb_ld(unsigned* p)              { return __hip_atomic_load(p, __ATOMIC_RELAXED, __HIP_MEMORY_SCOPE_AGENT); }
__device__ __forceinline__ unsigned xb_add(unsigned* p, unsigned v) { return __hip_atomic_fetch_add(p, v, __ATOMIC_RELAXED, __HIP_MEMORY_SCOPE_AGENT); }
__device__ __forceinline__ unsigned xb_xcc_id() { return (unsigned)__builtin_amdgcn_s_getreg((3 << 11) | 20) & 0xFu; }
#define XB_SPIN(cond, bar) do { unsigned _sp = 0; while (cond) { __builtin_amdgcn_s_sleep(1); \
    if ((++_sp & 255u) == 0u) { if (xb_ld(&(bar)[XB_TMO])) break; if (_sp > XB_SPIN_CAP) { atomicAdd(&(bar)[XB_TMO], 1u); break; } } } } while (0)

struct XcdBarrier {
    unsigned* bar; unsigned x;
    volatile LAS unsigned* st;
};

__device__ __forceinline__ XcdBarrier xcd_barrier_post(unsigned* bar, volatile LAS unsigned* st) {
    XcdBarrier b; b.bar = bar; b.x = xb_xcc_id(); b.st = st;
    if (threadIdx.x == 0) (void)xb_add(&bar[XB_XCNT(b.x)], 1u);
    return b;
}
__device__ __forceinline__ void xcd_barrier_complete(unsigned* bar, unsigned x, unsigned& nloc, unsigned& nx) {
    const unsigned G = gridDim.x * gridDim.y * gridDim.z;
    unsigned sum, cnt, mine, sp = 0u;
    for (;;) {
        sum = 0u; cnt = 0u; mine = 0u;
#pragma unroll
        for (unsigned j = 0; j < 16; ++j) { const unsigned c = xb_ld(&bar[XB_XCNT(j)]); sum += c; cnt += (c > 0u) ? 1u : 0u; mine = (j == x) ? c : mine; }
        if (sum == G) break;
        __builtin_amdgcn_s_sleep(1);
        if ((++sp & 255u) == 0u) { if (xb_ld(&bar[XB_TMO])) break; if (sp > XB_SPIN_CAP) { atomicAdd(&bar[XB_TMO], 1u); break; } }
    }
    nloc = mine > 0u ? mine : 1u; nx = cnt > 0u ? cnt : 1u;
}

__device__ __forceinline__ void xcd_barrier(const XcdBarrier& b) {
    asm volatile("s_waitcnt vmcnt(0)" ::: "memory");
    __syncthreads();
    if (threadIdx.x == 0) {
        unsigned* bar = b.bar;
        __builtin_amdgcn_s_waitcnt(0);
        unsigned nloc = b.st[0], nx = b.st[1];
        if (nloc == 0u) { xcd_barrier_complete(bar, b.x, nloc, nx); b.st[0] = nloc; b.st[1] = nx; }
        const unsigned old = xb_add(&bar[XB_XSUB(b.x)], 1u);
        const unsigned gen = old / nloc;
        if (old + 1u == (gen + 1u) * nloc) {
            __builtin_amdgcn_fence(__ATOMIC_RELEASE, "agent");
            asm volatile("s_waitcnt vmcnt(0)" ::: "memory");
            const unsigned og = xb_add(&bar[XB_TOP], 1u);
            const unsigned tg = og / nx;
            if (og + 1u == (tg + 1u) * nx) xb_add(&bar[XB_TOPGEN], 1u);
            else XB_SPIN(xb_ld(&bar[XB_TOPGEN]) == tg, bar);
            __builtin_amdgcn_fence(__ATOMIC_ACQUIRE, "agent");
            xb_add(&bar[XB_XGEN(b.x)], 1u);
            asm volatile("s_waitcnt vmcnt(0)" ::: "memory");
        } else {
            XB_SPIN(xb_ld(&bar[XB_XGEN(b.x)]) == gen, bar);
            __builtin_amdgcn_fence(__ATOMIC_ACQUIRE, "agent");
            asm volatile("s_waitcnt vmcnt(0)" ::: "memory");
        }
    }
    __syncthreads();
}


__device__ __forceinline__ void xcd_arrive(const XcdBarrier& b) {
    asm volatile("s_waitcnt vmcnt(0)" ::: "memory");
    __syncthreads();
    if (threadIdx.x == 0) {
        unsigned* bar = b.bar;
        __builtin_amdgcn_s_waitcnt(0);
        unsigned nloc = b.st[0], nx = b.st[1];
        if (nloc == 0u) { xcd_barrier_complete(bar, b.x, nloc, nx); b.st[0] = nloc; b.st[1] = nx; }
        const unsigned old = xb_add(&bar[XB_XSUB(b.x)], 1u);
        const unsigned gen = old / nloc;
        if (old + 1u == (gen + 1u) * nloc) {
            __builtin_amdgcn_fence(__ATOMIC_RELEASE, "agent");
            asm volatile("s_waitcnt vmcnt(0)" ::: "memory");
            const unsigned og = xb_add(&bar[XB_TOP], 1u);
            const unsigned tg = og / nx;
            if (og + 1u == (tg + 1u) * nx) xb_add(&bar[XB_TOPGEN], 1u);
            else XB_SPIN(xb_ld(&bar[XB_TOPGEN]) == tg, bar);
            __builtin_amdgcn_fence(__ATOMIC_ACQUIRE, "agent");
            xb_add(&bar[XB_XGEN(b.x)], 1u);
            asm volatile("s_waitcnt vmcnt(0)" ::: "memory");
            b.st[4] = 1u;
        } else { b.st[4] = 0u; b.st[5] = gen; }
    }
}
__device__ __forceinline__ void xcd_wait(const XcdBarrier& b) {
    if (threadIdx.x == 0) {
        if (b.st[4] == 0u) { unsigned* bar = b.bar; const unsigned gen = b.st[5];
            XB_SPIN(xb_ld(&bar[XB_XGEN(b.x)]) == gen, bar);
            __builtin_amdgcn_fence(__ATOMIC_ACQUIRE, "agent");
            asm volatile("s_waitcnt vmcnt(0)" ::: "memory"); }
    }
    __syncthreads();
}

struct Frame {
    LAS unsigned char* lds;
    volatile LAS unsigned* MISC;
    gu32* ctl;
    int tid, lane, wave;
    int vcu, G;
    const float* in[27]; float* out; unsigned char* ws;
};
enum { I_X = 0, I_C, I_ADAW, I_ADAB, I_GMIX, I_GFFN, I_GFIN, I_WIN, I_LQ1, I_LK1, I_LQ2, I_LK2, I_SUBLN, I_RELT, I_CONVW, I_CONVB, I_DTBF, I_DTBB, I_ALOGF, I_ALOGB, I_DSKIP, I_SSMG, I_WOUT, I_ROUTW, I_WGATE, I_WUP, I_WDOWN };

__device__ __forceinline__ float wave_sum(float v) {
#pragma unroll
    for (int o = 1; o < 64; o <<= 1) v += __shfl_xor(v, o);
    return v;
}
__device__ __forceinline__ float reduce16(const float (&p)[16], int lane) {
    float q8[8], q4[4], q2[2], q1;
    const bool u5 = (lane & 32) != 0, u4 = (lane & 16) != 0, u3 = (lane & 8) != 0, u2 = (lane & 4) != 0;
#pragma unroll
    for (int i = 0; i < 8; ++i) { const float send = u5 ? p[i] : p[i + 8], keep = u5 ? p[i + 8] : p[i]; q8[i] = keep + __shfl_xor(send, 32); }
#pragma unroll
    for (int i = 0; i < 4; ++i) { const float send = u4 ? q8[i] : q8[i + 4], keep = u4 ? q8[i + 4] : q8[i]; q4[i] = keep + __shfl_xor(send, 16); }
#pragma unroll
    for (int i = 0; i < 2; ++i) { const float send = u3 ? q4[i] : q4[i + 2], keep = u3 ? q4[i + 2] : q4[i]; q2[i] = keep + __shfl_xor(send, 8); }
    { const float send = u2 ? q2[0] : q2[1], keep = u2 ? q2[1] : q2[0]; q1 = keep + __shfl_xor(send, 4); }
    q1 += __shfl_xor(q1, 2); q1 += __shfl_xor(q1, 1);
    return q1;
}
__device__ __forceinline__ int reduce16_index(int lane) { return ((lane >> 5) & 1) * 8 + ((lane >> 4) & 1) * 4 + ((lane >> 3) & 1) * 2 + ((lane >> 2) & 1); }

constexpr int P0_ITEMS_DENSE = 16 * 89 + 16 * 32, P0_ITEMS_ALL = P0_ITEMS_DENSE + 3 * 16 * 1408;
struct P0Item { const float* src; unsigned char* dst; int ldw, pitch, fp8, nv; };
__device__ __forceinline__ void p0_load(const P0Item& d, float (&v)[32], int lane) {
    const int cl = (lane & 31) < d.nv ? (lane & 31) : (lane & 15);
#pragma unroll
    for (int i = 0; i < 32; ++i) { const int kk = 2 * i + (lane >> 5); v[i] = __builtin_nontemporal_load(d.src + (size_t)kk * d.ldw + cl); }
}
__device__ __forceinline__ void p0_store(const P0Item& d, const float (&v)[32], LAS float* scr, int lane) {
#pragma unroll
    for (int i = 0; i < 32; ++i) { const int kk = 2 * i + (lane >> 5); scr[kk * 33 + (lane & 31)] = v[i]; }
    LDS_WAIT(); asm volatile("" ::: "memory");
    if (d.fp8) {
#pragma unroll
        for (int j = 0; j < 2; ++j) { const int id = lane + 64 * j, n = id >> 2, kc = id & 3; const LAS float* s = scr + (16 * kc) * 33 + n;
            v4u o;
            o.x = pg8::pk_fp8x4(s[0 * 33] * pg8::WSCALE, s[1 * 33] * pg8::WSCALE, s[2 * 33] * pg8::WSCALE, s[3 * 33] * pg8::WSCALE);
            o.y = pg8::pk_fp8x4(s[4 * 33] * pg8::WSCALE, s[5 * 33] * pg8::WSCALE, s[6 * 33] * pg8::WSCALE, s[7 * 33] * pg8::WSCALE);
            o.z = pg8::pk_fp8x4(s[8 * 33] * pg8::WSCALE, s[9 * 33] * pg8::WSCALE, s[10 * 33] * pg8::WSCALE, s[11 * 33] * pg8::WSCALE);
            o.w = pg8::pk_fp8x4(s[12 * 33] * pg8::WSCALE, s[13 * 33] * pg8::WSCALE, s[14 * 33] * pg8::WSCALE, s[15 * 33] * pg8::WSCALE);
            __builtin_nontemporal_store(o, (GAS v4u*)(d.dst + (size_t)n * d.pitch + 16 * kc)); }
    } else {
        const int c = lane & 7;
#pragma unroll
        for (int j = 0; j < 4; ++j) { const int n = (lane >> 3) + 8 * j; const LAS float* s = scr + (8 * c) * 33 + n;
            v4u o; o.x = pk2(s[0 * 33], s[1 * 33]); o.y = pk2(s[2 * 33], s[3 * 33]); o.z = pk2(s[4 * 33], s[5 * 33]); o.w = pk2(s[6 * 33], s[7 * 33]);
            __builtin_nontemporal_store(o, (GAS v4u*)(d.dst + (size_t)n * d.pitch + 16 * c)); }
    }
    LDS_WAIT(); asm volatile("" ::: "memory");
}
__device__ __forceinline__ P0Item p0_decode(Frame& F, int it) {
    constexpr int I_IN = 16 * 89, I_OUT = 16 * 32, I_EXP = 1408, I_G = 16 * I_EXP;
    P0Item d; int r = it; d.nv = 32;
    if (r < I_IN) { const int kb = r / 89, nb = r % 89; d.nv = nb == 88 ? 16 : 32; d.src = F.in[I_WIN] + (size_t)(kb * 64) * NINC + nb * 32; d.ldw = NINC; d.pitch = 2048; d.fp8 = 0; d.dst = F.ws + WS_WIN + (size_t)(nb * 32) * 2048 + kb * 128; return d; } r -= I_IN;
    if (r < I_OUT) { const int kb = r / 32, nb = r % 32; d.src = F.in[I_WOUT] + (size_t)(kb * 64) * 1024 + nb * 32; d.ldw = 1024; d.pitch = 2048; d.fp8 = 0; d.dst = F.ws + WS_WOUT + (size_t)(nb * 32) * 2048 + kb * 128; return d; } r -= I_OUT;
    if (r < 2 * I_G) { const int up = r >= I_G; if (up) r -= I_G; const int e = r / I_EXP, rr = r % I_EXP, kb = rr / 88, nb = rr % 88, n0 = nb * 32;
        d.src = (up ? F.in[I_WUP] : F.in[I_WGATE]) + (size_t)e * 1024 * FFD + (size_t)(kb * 64) * FFD + n0; d.ldw = FFD; d.pitch = 1024; d.fp8 = 1;
        d.dst = F.ws + WS_WGU + (size_t)(e * 5632 + 256 * (n0 >> 7) + (n0 & 127) + (up ? 128 : 0)) * 1024 + kb * 64; return d; } r -= 2 * I_G;
    { const int e = r / I_EXP, rr = r % I_EXP, kb = rr / 32, nb = rr % 32;
        d.src = F.in[I_WDOWN] + (size_t)e * FFD * 1024 + (size_t)(kb * 64) * 1024 + nb * 32; d.ldw = 1024; d.pitch = FFD; d.fp8 = 1;
        d.dst = F.ws + WS_WD + (size_t)(e * 1024 + nb * 32) * FFD + kb * 64; return d; }
}

constexpr int BG_TILE_OFF = 69632, BG_TAB_OFF = BG_TILE_OFF + NWAVES * 8192, BG_MAXIT = 40;
static_assert(BG_TAB_OFF + NWAVES * BG_MAXIT * 32 <= LDSCTL_OFF, "bg table");
struct BgConv {
    Frame* F; unsigned ldsb; LAS float* tile; LAS unsigned* tab; int k, nit, inflight; unsigned char* dst; int pitch;
    __device__ __forceinline__ void init(Frame& Fr) { F = &Fr; tile = (LAS float*)(Fr.lds + RING_OFF + BG_TILE_OFF + Fr.wave * 8192); ldsb = (unsigned)(uintptr_t)tile;
        tab = (LAS unsigned*)(Fr.lds + RING_OFF + BG_TAB_OFF + Fr.wave * (BG_MAXIT * 32));
        const int first = P0_ITEMS_DENSE + Fr.vcu * NWAVES + Fr.wave, stride = Fr.G * NWAVES;
        nit = first < P0_ITEMS_ALL ? (P0_ITEMS_ALL - 1 - first) / stride + 1 : 0; if (nit > BG_MAXIT) nit = BG_MAXIT;
        if (Fr.lane < nit) { const P0Item d = p0_decode(Fr, first + Fr.lane * stride); LAS unsigned* e = tab + Fr.lane * 8;
            const unsigned long long sp = (unsigned long long)(uintptr_t)d.src, dp = (unsigned long long)(uintptr_t)d.dst;
            e[0] = (unsigned)sp; e[1] = (unsigned)(sp >> 32); e[2] = (unsigned)dp; e[3] = (unsigned)(dp >> 32); e[4] = (unsigned)d.ldw * 4u; e[5] = (unsigned)d.pitch; }
        LDS_WAIT(); asm volatile("" ::: "memory");
        k = 0; inflight = 0; dst = nullptr; pitch = 0; }
    __device__ __forceinline__ int issue_half(int half) {
        if (k >= nit) return 0;
        const LAS unsigned* e = tab + k * 8;
        const v4u e0 = *(const LAS v4u*)e; const v2u e1 = *(const LAS v2u*)(e + 4);
        const unsigned s0 = __builtin_amdgcn_readfirstlane(e0.x), s1 = __builtin_amdgcn_readfirstlane(e0.y), d0 = __builtin_amdgcn_readfirstlane(e0.z), d1 = __builtin_amdgcn_readfirstlane(e0.w);
        const unsigned ldwb = __builtin_amdgcn_readfirstlane(e1.x), pt = __builtin_amdgcn_readfirstlane(e1.y);
        unsigned long long sb = (((unsigned long long)s1 << 32) | s0) + (unsigned long long)ldwb * (half ? 32ull : 0ull);
        const unsigned rowoff = (unsigned)(F->lane >> 3) * ldwb, l16 = (unsigned)(F->lane & 7) * 16u;
        const unsigned lb = ldsb + (half ? 4096u : 0u), sw = half ? 64u : 0u;
#pragma unroll
        for (int i = 0; i < 4; ++i) { unsigned keep; const unsigned ld = (unsigned)__builtin_amdgcn_readfirstlane((int)(lb + i * 1024));
            const unsigned vo = rowoff + ((l16 - 32u * (i >> 1) - sw) & 112u);
            asm volatile("s_mov_b32 %0, m0\n\ts_mov_b32 m0, %3\n\ts_nop 0\n\tglobal_load_lds_dwordx4 %1, %2 nt\n\ts_mov_b32 m0, %0" : "=&s"(keep) : "v"(vo), "s"(sb), "s"(ld) : "memory");
            sb += (unsigned long long)ldwb * 8ull; }
        if (half) { dst = (unsigned char*)(uintptr_t)(((unsigned long long)d1 << 32) | d0); pitch = (int)pt; inflight = 1; ++k; }
        return 4;
    }
    __device__ __forceinline__ int issue() {
        if (k >= nit) return 0;
        const LAS unsigned* e = tab + k * 8;
        const v4u e0 = *(const LAS v4u*)e; const v2u e1 = *(const LAS v2u*)(e + 4);
        const unsigned s0 = __builtin_amdgcn_readfirstlane(e0.x), s1 = __builtin_amdgcn_readfirstlane(e0.y), d0 = __builtin_amdgcn_readfirstlane(e0.z), d1 = __builtin_amdgcn_readfirstlane(e0.w);
        const unsigned ldwb = __builtin_amdgcn_readfirstlane(e1.x), pt = __builtin_amdgcn_readfirstlane(e1.y);
        unsigned long long sb = ((unsigned long long)s1 << 32) | s0;
        const unsigned rowoff = (unsigned)(F->lane >> 3) * ldwb, l16 = (unsigned)(F->lane & 7) * 16u;
#pragma unroll
        for (int i = 0; i < 8; ++i) { unsigned keep; const unsigned ld = (unsigned)__builtin_amdgcn_readfirstlane((int)(ldsb + i * 1024));
            const unsigned vo = rowoff + ((l16 - 32u * (i >> 1)) & 112u);
            asm volatile("s_mov_b32 %0, m0\n\ts_mov_b32 m0, %3\n\ts_nop 0\n\tglobal_load_lds_dwordx4 %1, %2 nt\n\ts_mov_b32 m0, %0" : "=&s"(keep) : "v"(vo), "s"(sb), "s"(ld) : "memory");
            sb += (unsigned long long)ldwb * 8ull; }
        dst = (unsigned char*)(uintptr_t)(((unsigned long long)d1 << 32) | d0); pitch = (int)pt; inflight = 1; ++k; return 8;
    }
    __device__ __forceinline__ int process() {
        if (!inflight) return 0;
        const int lane = F->lane;
#pragma unroll
        for (int j = 0; j < 2; ++j) { const int id = lane + 64 * j, n = id >> 2, kc = id & 3; const LAS float* sp = tile + (16 * kc) * 32 + ((n + 8 * kc) & 31);
            v4u o;
            o.x = pg8::pk_fp8x4(sp[0 * 32] * pg8::WSCALE, sp[1 * 32] * pg8::WSCALE, sp[2 * 32] * pg8::WSCALE, sp[3 * 32] * pg8::WSCALE);
            o.y = pg8::pk_fp8x4(sp[4 * 32] * pg8::WSCALE, sp[5 * 32] * pg8::WSCALE, sp[6 * 32] * pg8::WSCALE, sp[7 * 32] * pg8::WSCALE);
            o.z = pg8::pk_fp8x4(sp[8 * 32] * pg8::WSCALE, sp[9 * 32] * pg8::WSCALE, sp[10 * 32] * pg8::WSCALE, sp[11 * 32] * pg8::WSCALE);
            o.w = pg8::pk_fp8x4(sp[12 * 32] * pg8::WSCALE, sp[13 * 32] * pg8::WSCALE, sp[14 * 32] * pg8::WSCALE, sp[15 * 32] * pg8::WSCALE);
            __builtin_nontemporal_store(o, (GAS v4u*)(dst + (size_t)n * pitch + 16 * kc)); asm volatile("" ::: "memory"); }
        LDS_WAIT(); asm volatile("" ::: "memory");
        inflight = 0; return 2;
    }
    __device__ __forceinline__ int step() { const int a = process(); return a + issue(); }
    __device__ __forceinline__ int stepB() { const int a = process(); return a + issue_half(0); }
    __device__ __forceinline__ void drain() { VM_WAIT(); process(); while (k < nit) { issue(); VM_WAIT(); process(); } }
};

__device__ __forceinline__ void p0_prologue(Frame& F) {
    const float* c_in = F.in[I_C]; const float* ada_w = F.in[I_ADAW]; const float* ada_b = F.in[I_ADAB];
    float* MOD = (float*)(F.ws + WS_MOD);
    {
        LAS float* sc = (LAS float*)F.lds; LAS float* red = sc + 8192;
        for (int i = F.tid; i < 8192; i += 512) sc[i] = silu(c_in[i]);
        __syncthreads();
        for (int cg = F.vcu; cg < 192; cg += F.G) {
            const int col = cg * 32 + (F.lane & 31), kp = F.lane >> 5;
            float a[8];
#pragma unroll
            for (int b = 0; b < 8; ++b) a[b] = 0.f;
#pragma unroll 4
            for (int i = 0; i < 64; ++i) { const int k = F.wave * 128 + 2 * i + kp; const float w = __builtin_nontemporal_load(ada_w + (size_t)k * 6144 + col);
#pragma unroll
                for (int b = 0; b < 8; ++b) a[b] += sc[b * 1024 + k] * w; }
#pragma unroll
            for (int b = 0; b < 8; ++b) a[b] += __shfl_xor(a[b], 32);
            if (F.lane < 32) {
#pragma unroll
                for (int b = 0; b < 8; ++b) red[(F.wave * 8 + b) * 32 + F.lane] = a[b]; }
            __syncthreads();
            if (F.tid < 256) { const int b = F.tid >> 5, cl = F.tid & 31; float s = ada_b[cg * 32 + cl];
#pragma unroll
                for (int w = 0; w < 8; ++w) s += red[(w * 8 + b) * 32 + cl];
                MOD[b * 6144 + cg * 32 + cl] = s; }
            __syncthreads();
        }
    }
    {
        float* TAB = (float*)(F.ws + WS_TAB); const float* relt = F.in[I_RELT];
        for (int idx = F.vcu * 512 + F.tid; idx < 4 * 4096; idx += F.G * 512) {
            const int h = idx >> 12, i = idx & 4095; float v = 0.f;
            if (i < 4095) { const int rel = i - 2047, n = rel < 0 ? -rel : rel, ret = rel > 0 ? 16 : 0; int bk;
                if (n < 8) bk = ret + n;
                else { int large = 8 + (int)(logf((float)n / 8.0f) / 2.772588722239781f * 8.0f); large = large < 15 ? large : 15; bk = ret + large; }
                v = relt[bk * 4 + h] * LOG2E; }
            TAB[idx] = v;
        }
        if (blockIdx.x == 0 && F.wave == 0) {
            const float s1 = wave_sum(F.in[I_LQ1][F.lane] * F.in[I_LK1][F.lane]), s2 = wave_sum(F.in[I_LQ2][F.lane] * F.in[I_LK2][F.lane]);
            if (F.lane == 0) ((float*)(F.ws + WS_LAM))[0] = expf(s1) - expf(s2) + 0.2f;
        }
    }
    __syncthreads();
    {
        LAS float* scr = (LAS float*)(F.lds + RING_OFF + F.wave * 16384);
        const int gw = F.vcu * NWAVES + F.wave, NGW = F.G * NWAVES;
        constexpr int NITEMS = P0_ITEMS_DENSE;
        if (gw < NITEMS) {
            P0Item d0 = p0_decode(F, gw), d1 = d0; float a[32], bq[32], cq[32];
            p0_load(d0, a, F.lane);
            if (gw + NGW < NITEMS) { d1 = p0_decode(F, gw + NGW); p0_load(d1, bq, F.lane); }
            for (int it = gw; it < NITEMS; it += NGW) {
                const int it2 = it + 2 * NGW; P0Item d2 = d1;
                if (it2 < NITEMS) { d2 = p0_decode(F, it2); p0_load(d2, cq, F.lane); }
                p0_store(d0, a, scr, F.lane);
                if (it + NGW >= NITEMS) break;
                d0 = d1; d1 = d2;
#pragma unroll
                for (int i = 0; i < 32; ++i) { a[i] = bq[i]; bq[i] = cq[i]; }
            }
        }
        for (int it = P0_ITEMS_DENSE + gw + BG_MAXIT * NGW; it < P0_ITEMS_ALL; it += NGW) { const P0Item d = p0_decode(F, it); float a[32]; p0_load(d, a, F.lane); p0_store(d, a, scr, F.lane); }
    }
}

__device__ __forceinline__ void p1_rows(Frame& F) {
    const float* x = F.in[I_X]; const float* gm = F.in[I_GMIX]; const float* MOD = (const float*)(F.ws + WS_MOD);
    bf16* XN = (bf16*)(F.ws + WS_XN);
    const int gw = F.vcu * NWAVES + F.wave, NGW = F.G * NWAVES;
    constexpr int R = 4;
    for (int m0 = gw * R; m0 < MTOK; m0 += NGW * R) {
        const int b = m0 >> 11;
        f32x4 v[R][4]; float ss[R];
#pragma unroll
        for (int r = 0; r < R; ++r) { const GAS f32x4* xr = (const GAS f32x4*)(x + (size_t)(m0 + r) * 1024) + F.lane;
#pragma unroll
            for (int j = 0; j < 4; ++j) v[r][j] = __builtin_nontemporal_load(xr + 64 * j); }
#pragma unroll
        for (int r = 0; r < R; ++r) { float t = 0.f;
#pragma unroll
            for (int j = 0; j < 4; ++j) t += (v[r][j].x * v[r][j].x + v[r][j].y * v[r][j].y) + (v[r][j].z * v[r][j].z + v[r][j].w * v[r][j].w);
            ss[r] = t; }
#pragma unroll
        for (int o = 1; o < 64; o <<= 1) {
#pragma unroll
            for (int r = 0; r < R; ++r) ss[r] += __shfl_xor(ss[r], o); }
#pragma unroll
        for (int r = 0; r < R; ++r) ss[r] = 1.0f / sqrtf(ss[r] * (1.f / 1024.f) + EPSN);
#pragma unroll
        for (int j = 0; j < 4; ++j) { const int col = 256 * j + 4 * F.lane;
            const f32x4 g = *(const f32x4*)(gm + col), sh = *(const f32x4*)(MOD + b * 6144 + col), sc = *(const f32x4*)(MOD + b * 6144 + 1024 + col);
#pragma unroll
            for (int r = 0; r < R; ++r) { const f32x4 h = (v[r][j] * ss[r] * g) * (sc + 1.0f) + sh;
                v2u o; o.x = pk2(h.x, h.y); o.y = pk2(h.z, h.w); ((GAS v2u*)(XN + (size_t)(m0 + r) * 1024) + F.lane)[64 * j] = o; } }
    }
}

#define MFMA16(a, b, c) __builtin_amdgcn_mfma_f32_16x16x32_bf16((a), (b), (c), 0, 0, 0)
constexpr int XTP = 136;
constexpr int SLP = 72;

__device__ __forceinline__ void ssd_a_unit(Frame& F, int b, int c, int g) {
    LAS bf16* XT = (LAS bf16*)F.lds;
    LAS bf16* BT = XT + 256 * XTP;
    LAS float* WF = (LAS float*)(BT + 64 * XTP);
    const bf16* P = (const bf16*)(F.ws + WS_P); bf16* XA = (bf16*)(F.ws + WS_XA);
    const float* convw = F.in[I_CONVW]; const float* convb = F.in[I_CONVB];
    const int row0 = b * SEQL + c * CHK, s0 = c * CHK;
    if (F.tid < 384) {
        const int cv = F.tid % 48, tg = F.tid / 48;
        const int ch = cv < 32 ? g * 256 + cv * 8 : (cv < 40 ? 512 + g * 64 + (cv - 32) * 8 : 640 + g * 64 + (cv - 40) * 8);
        float w[5][8], bb[8];
#pragma unroll
        for (int i = 0; i < 8; ++i) { bb[i] = convb[ch + i];
#pragma unroll
            for (int j = 0; j < 5; ++j) w[j][i] = convw[j * 768 + ch + i]; }
        LAS bf16* TT = cv < 32 ? XT + (cv * 8) * XTP : BT + ((cv - 32) * 8) * XTP;
#pragma unroll 1
        for (int pass = 0; pass < 2; ++pass) {
            const int t0 = 8 * (tg + 8 * pass);
            u16x8 rows[12];
#pragma unroll
            for (int i = 0; i < 12; ++i) { const int sq = s0 + t0 + i - 2;
                if (sq >= 0 && sq < SEQL) rows[i] = *(const u16x8*)(P + (size_t)(b * SEQL + sq) * NPC + XBCOFF + ch); else rows[i] = (u16x8){0, 0, 0, 0, 0, 0, 0, 0}; }
#pragma unroll
            for (int tt = 0; tt < 8; ++tt) {
                float a0[8];
                asm volatile("" : "+v"(rows[tt + 4]));
#pragma unroll
                for (int i = 0; i < 8; ++i) a0[i] = bb[i];
#pragma unroll
                for (int j = 0; j < 5; ++j)
#pragma unroll
                    for (int i = 0; i < 8; ++i) a0[i] += bf2f(rows[tt + j][i]) * w[j][i];
#pragma unroll
                for (int i = 0; i < 8; ++i) a0[i] = silu(a0[i]);
                v4u o; o.x = pk2(a0[0], a0[1]); o.y = pk2(a0[2], a0[3]); o.z = pk2(a0[4], a0[5]); o.w = pk2(a0[6], a0[7]);
                *(v4u*)(XA + (size_t)(row0 + t0 + tt) * 768 + ch) = o;
                if (cv < 40) {
#pragma unroll
                    for (int i = 0; i < 8; ++i) TT[i * XTP + t0 + tt] = (bf16)f2bf(a0[i]);
                }
            }
        }
    }
    {
        const int hh = F.wave & 3, dir = F.wave >> 2, h = g * 4 + hh;
        const float* DTRAW = (const float*)(F.ws + WS_DTRAW); float* DTV = (float*)(F.ws + WS_DTV); float* CS = (float*)(F.ws + WS_CS); float* TOT = (float*)(F.ws + WS_TOT);
        const float* pbias = dir ? F.in[I_DTBB] : F.in[I_DTBF]; const float* palog = dir ? F.in[I_ALOGB] : F.in[I_ALOGF];
        const float bias = pbias[h], A = -expf(palog[h]);
        float dt[2], av[2];
#pragma unroll
        for (int i = 0; i < 2; ++i) { const float xr = DTRAW[(size_t)(row0 + 2 * F.lane + i) * 16 + dir * 8 + h] + bias; dt[i] = xr > 20.f ? xr : log1pf(expf(xr)); av[i] = dt[i] * A; }
        float s = av[0] + av[1];
#pragma unroll
        for (int o = 1; o < 64; o <<= 1) { const float t = __shfl_up(s, o); if (F.lane >= o) s += t; }
        const float tot = __shfl(s, 63);
        float cs[2]; cs[1] = s; cs[0] = s - av[1];
#pragma unroll
        for (int i = 0; i < 2; ++i) { const int tl = 2 * F.lane + i; const size_t o = (size_t)(row0 + tl) * 16 + dir * 8 + h;
            const float cv = dir ? cs[i] - av[i] : cs[i];
            DTV[o] = dt[i]; CS[o] = cv;
            WF[(dir * 4 + hh) * 128 + tl] = (dir ? __expf(cv) : __expf(tot - cs[i])) * dt[i]; }
        if (F.lane == 0) TOT[(b * NCH + c) * 16 + dir * 8 + h] = tot;
    }
    __syncthreads();
    {
        const int hh = F.wave & 3, dir = F.wave >> 2, h = g * 4 + hh, l15 = F.lane & 15, lq = F.lane >> 4;
        f32x4 acc[4][4];
#pragma unroll
        for (int i = 0; i < 4; ++i)
#pragma unroll
            for (int j = 0; j < 4; ++j) acc[i][j] = (f32x4){0.f, 0.f, 0.f, 0.f};
#pragma unroll
        for (int ks = 0; ks < 4; ++ks) {
            const int k0 = 32 * ks + 8 * lq;
            const f32x4 w0 = *(const LAS f32x4*)(WF + (dir * 4 + hh) * 128 + k0), w1 = *(const LAS f32x4*)(WF + (dir * 4 + hh) * 128 + k0 + 4);
            bf16x8 af[4], bfr[4];
#pragma unroll
            for (int mt = 0; mt < 4; ++mt) af[mt] = *(const LAS bf16x8*)(XT + (hh * 64 + 16 * mt + l15) * XTP + k0);
#pragma unroll
            for (int nt = 0; nt < 4; ++nt) { const u16x8 raw = *(const LAS u16x8*)(BT + (16 * nt + l15) * XTP + k0);
                v4u pk; pk.x = pk2(bf2f(raw[0]) * w0.x, bf2f(raw[1]) * w0.y); pk.y = pk2(bf2f(raw[2]) * w0.z, bf2f(raw[3]) * w0.w);
                pk.z = pk2(bf2f(raw[4]) * w1.x, bf2f(raw[5]) * w1.y); pk.w = pk2(bf2f(raw[6]) * w1.z, bf2f(raw[7]) * w1.w);
                bfr[nt] = __builtin_bit_cast(bf16x8, pk); }
#pragma unroll
            for (int mt = 0; mt < 4; ++mt)
#pragma unroll
                for (int nt = 0; nt < 4; ++nt) acc[mt][nt] = MFMA16(af[mt], bfr[nt], acc[mt][nt]);
        }
        float* ST = (float*)(F.ws + WS_ST) + ((size_t)(((b * NCH + c) * 8 + h) * 2 + dir)) * 4096;
#pragma unroll
        for (int mt = 0; mt < 4; ++mt)
#pragma unroll
            for (int nt = 0; nt < 4; ++nt)
#pragma unroll
                for (int r = 0; r < 4; ++r) ST[(16 * mt + 4 * lq + r) * 64 + 16 * nt + l15] = acc[mt][nt][r];
    }
    __syncthreads();
}

__device__ __forceinline__ void ps_scan(Frame& F) {
    const float* ST = (const float*)(F.ws + WS_ST); const float* TOT = (const float*)(F.ws + WS_TOT); bf16* SIN = (bf16*)(F.ws + WS_SIN);
    for (int gt = F.vcu * 512 + F.tid; gt < 128 * 1024; gt += F.G * 512) {
        const int seq = gt >> 10, el = (gt & 1023) * 4, b = seq >> 4, h = (seq >> 1) & 7, dir = seq & 1;
        f32x4 st[16]; float et[16];
#pragma unroll
        for (int c = 0; c < 16; ++c) { st[c] = *(const f32x4*)(ST + ((size_t)(((b * NCH + c) * 8 + h) * 2 + dir)) * 4096 + el); et[c] = __expf(TOT[(b * NCH + c) * 16 + dir * 8 + h]); }
        f32x4 run = (f32x4){0.f, 0.f, 0.f, 0.f};
        if (dir == 0) {
#pragma unroll
            for (int c = 0; c < 16; ++c) { v2u o; o.x = pk2(run.x, run.y); o.y = pk2(run.z, run.w); *(v2u*)(SIN + ((size_t)(((b * NCH + c) * 8 + h) * 2 + dir)) * 4096 + el) = o; run = run * et[c] + st[c]; }
        } else {
#pragma unroll
            for (int c = 15; c >= 0; --c) { v2u o; o.x = pk2(run.x, run.y); o.y = pk2(run.z, run.w); *(v2u*)(SIN + ((size_t)(((b * NCH + c) * 8 + h) * 2 + dir)) * 4096 + el) = o; run = run * et[c] + st[c]; }
        }
    }
}

__device__ __forceinline__ void ssd_b_unit(Frame& F, int b, int c, int g, const XcdBarrier& wb, bool pend) {
    LAS bf16* XT2 = (LAS bf16*)F.lds;
    LAS bf16* SL = XT2 + 128 * XTP;
    LAS bf16* WL = SL + 4 * 64 * SLP;
    LAS float* AR = (LAS float*)(WL + 8 * 16 * XTP);
    const bf16* XA = (const bf16*)(F.ws + WS_XA); const bf16* P = (const bf16*)(F.ws + WS_P); bf16* AO = (bf16*)(F.ws + WS_AO);
    const float* DTV = (const float*)(F.ws + WS_DTV); const float* CS = (const float*)(F.ws + WS_CS); const float* TOT = (const float*)(F.ws + WS_TOT);
    const int row0 = b * SEQL + c * CHK, l15 = F.lane & 15, lq = F.lane >> 4, w = F.wave;
    bf16x8 cf[2];
#pragma unroll
    for (int ks = 0; ks < 2; ++ks) cf[ks] = *(const bf16x8*)(XA + (size_t)(row0 + 16 * w + l15) * 768 + 640 + g * 64 + 32 * ks + 8 * lq);
    f32x4 G[8];
#pragma unroll
    for (int j = 0; j < 8; ++j) { G[j] = (f32x4){0.f, 0.f, 0.f, 0.f};
#pragma unroll
        for (int ks = 0; ks < 2; ++ks) { const bf16x8 bfr = *(const bf16x8*)(XA + (size_t)(row0 + 16 * j + l15) * 768 + 512 + g * 64 + 32 * ks + 8 * lq); G[j] = MFMA16(cf[ks], bfr, G[j]); } }
    unsigned ygp[4][4][2];
    float ssq = 0.f;
#pragma unroll 1
    for (int hp = 0; hp < 2; ++hp) {
        __syncthreads();
        for (int v = F.tid; v < CHK * 16; v += 512) { const int tl = v >> 4, cv = v & 15;
            const u16x8 pv = *(const u16x8*)(XA + (size_t)(row0 + tl) * 768 + g * 256 + hp * 128 + cv * 8);
#pragma unroll
            for (int i = 0; i < 8; ++i) XT2[(cv * 8 + i) * XTP + tl] = pv[i]; }
        for (int v = F.tid; v < 1024; v += 512) { const int kind = v >> 8, hh2 = (v >> 7) & 1, tl = v & 127, h = g * 4 + hp * 2 + hh2;
            const size_t o = (size_t)(row0 + tl) * 16 + ((kind & 1) ? 8 : 0) + h;
            AR[v] = (kind < 2) ? CS[o] : DTV[o]; }
        if (pend) { xcd_wait(wb); pend = false; }
        { const int combo = F.tid >> 7, hh2 = combo & 1, dir = combo >> 1, h = g * 4 + hp * 2 + hh2, idx = (F.tid & 127) * 32, p = idx >> 6, n = idx & 63;
            const bf16* src = (const bf16*)(F.ws + WS_SIN) + ((size_t)(((b * NCH + c) * 8 + h) * 2 + dir)) * 4096 + idx;
            v4u t[4];
#pragma unroll
            for (int q = 0; q < 4; ++q) t[q] = *(const v4u*)(src + 8 * q);
#pragma unroll
            for (int q = 0; q < 4; ++q) *(LAS v4u*)(SL + (combo * 64 + p) * SLP + n + 8 * q) = t[q]; }
        __syncthreads();
#pragma unroll 1
        for (int hh2 = 0; hh2 < 2; ++hh2) {
            const int hd = hp * 2 + hh2, h = g * 4 + hd;
            const LAS float* csf = AR + (0 * 2 + hh2) * 128; const LAS float* ecsb = AR + (1 * 2 + hh2) * 128; const LAS float* dtf = AR + (2 * 2 + hh2) * 128; const LAS float* dtb = AR + (3 * 2 + hh2) * 128;
            v2u zq[4];
#pragma unroll
            for (int pt = 0; pt < 4; ++pt) zq[pt] = *(const v2u*)(P + (size_t)(row0 + 16 * w + l15) * NPC + ZOFF + h * 64 + 16 * pt + 4 * lq);
            const float totb = TOT[(b * NCH + c) * 16 + 8 + h], dsk = F.in[I_DSKIP][h];
            float csl[4], ecl[4];
#pragma unroll
            for (int r = 0; r < 4; ++r) { csl[r] = csf[16 * w + 4 * lq + r]; ecl[r] = ecsb[16 * w + 4 * lq + r]; }
            LAS bf16* wl = WL + w * 16 * XTP;
#pragma unroll
            for (int j = 0; j < 8; ++j) { const int s = 16 * j + l15; const float cs_s = csf[s], ec_s = ecsb[s], df = dtf[s], db = dtb[s];
#pragma unroll
                for (int r = 0; r < 4; ++r) { const int l = 16 * w + 4 * lq + r;
                    const float arg = (s < l) ? (csl[r] - cs_s) : (ec_s - ecl[r]); const float mul = (s < l) ? df : db;
                    float val = G[j][r] * __expf(arg) * mul; if (s == l) val = G[j][r] * (df + db);
                    wl[(4 * lq + r) * XTP + s] = (bf16)f2bf(val); } }
            LDS_WAIT(); asm volatile("" ::: "memory");
            f32x4 yd[4], yf[4], yb[4];
#pragma unroll
            for (int pt = 0; pt < 4; ++pt) { yd[pt] = (f32x4){0.f, 0.f, 0.f, 0.f}; yf[pt] = yd[pt]; yb[pt] = yd[pt]; }
#pragma unroll
            for (int ks = 0; ks < 4; ++ks) { const bf16x8 af = *(const LAS bf16x8*)(wl + l15 * XTP + 32 * ks + 8 * lq);
#pragma unroll
                for (int pt = 0; pt < 4; ++pt) { const bf16x8 bfr = *(const LAS bf16x8*)(XT2 + (hh2 * 64 + 16 * pt + l15) * XTP + 32 * ks + 8 * lq); yd[pt] = MFMA16(bfr, af, yd[pt]); } }
#pragma unroll
            for (int ks = 0; ks < 2; ++ks)
#pragma unroll
                for (int pt = 0; pt < 4; ++pt) {
                    const bf16x8 bf_ = *(const LAS bf16x8*)(SL + ((0 * 2 + hh2) * 64 + 16 * pt + l15) * SLP + 32 * ks + 8 * lq); yf[pt] = MFMA16(bf_, cf[ks], yf[pt]);
                    const bf16x8 bb_ = *(const LAS bf16x8*)(SL + ((1 * 2 + hh2) * 64 + 16 * pt + l15) * SLP + 32 * ks + 8 * lq); yb[pt] = MFMA16(bb_, cf[ks], yb[pt]); }
            float yt[4][4];
            { const int l = 16 * w + l15; const float ef = __expf(csf[l]), eb = __expf(totb - ecsb[l]);
#pragma unroll
                for (int pt = 0; pt < 4; ++pt) { const int p0 = 16 * pt + 4 * lq;
                    const v2u zz = zq[pt];
                    const float zf[4] = {__builtin_bit_cast(float, zz.x << 16), __builtin_bit_cast(float, zz.x & 0xffff0000u), __builtin_bit_cast(float, zz.y << 16), __builtin_bit_cast(float, zz.y & 0xffff0000u)};
#pragma unroll
                    for (int r = 0; r < 4; ++r) { const float xv = bf2f(XT2[(hh2 * 64 + p0 + r) * XTP + l]);
                        const float y = (yd[pt][r] + ef * yf[pt][r] + eb * yb[pt][r] + dsk * xv) * silu(zf[r]);
                        yt[pt][r] = y; ssq += y * y; } } }
            unsigned pk[4][2];
#pragma unroll
            for (int pt = 0; pt < 4; ++pt) { pk[pt][0] = pk2(yt[pt][0], yt[pt][1]); pk[pt][1] = pk2(yt[pt][2], yt[pt][3]); }
#define YG_COPY(HD) do { _Pragma("unroll") for (int pt = 0; pt < 4; ++pt) { ygp[HD][pt][0] = pk[pt][0]; ygp[HD][pt][1] = pk[pt][1]; } } while (0)
            if (hd == 0) YG_COPY(0); else if (hd == 1) YG_COPY(1); else if (hd == 2) YG_COPY(2); else YG_COPY(3);
#undef YG_COPY
        }
    }
    const float* ng = F.in[I_SSMG];
    ssq += __shfl_xor(ssq, 16); ssq += __shfl_xor(ssq, 32);
    { const float rstd = 1.0f / sqrtf(ssq * (1.f / 256.f) + EPSN); const int l = 16 * w + l15;
#pragma unroll
        for (int hd = 0; hd < 4; ++hd)
#pragma unroll
            for (int pt = 0; pt < 4; ++pt) { const int chn = g * 256 + hd * 64 + 16 * pt + 4 * lq; const f32x4 gg = *(const f32x4*)(ng + chn);
                const unsigned p01 = ygp[hd][pt][0], p23 = ygp[hd][pt][1];
                v2u o; o.x = pk2(__builtin_bit_cast(float, p01 << 16) * rstd * gg.x, __builtin_bit_cast(float, p01 & 0xffff0000u) * rstd * gg.y);
                o.y = pk2(__builtin_bit_cast(float, p23 << 16) * rstd * gg.z, __builtin_bit_cast(float, p23 & 0xffff0000u) * rstd * gg.w);
                *(v2u*)(AO + (size_t)(row0 + l) * 1024 + 512 + chn) = o; } }
    __syncthreads();
}

__device__ __forceinline__ void attn_finalize_rows(Frame& F) {
    const bf16* R0 = (const bf16*)(F.ws + WS_AORAW); const bf16* R1 = R0 + (size_t)MTOK * 512; bf16* AO = (bf16*)(F.ws + WS_AO);
    const float lam = ((const float*)(F.ws + WS_LAM))[0]; const float* sg = F.in[I_SUBLN];
    const int gw = F.vcu * NWAVES + F.wave, NGW = F.G * NWAVES;
    const int d0 = (F.lane & 15) * 8;
    float gv[8];
#pragma unroll
    for (int i = 0; i < 8; ++i) gv[i] = sg[d0 + i] * 0.8f;
    constexpr int R = 4;
    for (int m0 = gw * R; m0 < MTOK; m0 += NGW * R) {
        u16x8 a[R], bq[R];
#pragma unroll
        for (int r = 0; r < R; ++r) { a[r] = *(const u16x8*)(R0 + (size_t)(m0 + r) * 512 + F.lane * 8); bq[r] = *(const u16x8*)(R1 + (size_t)(m0 + r) * 512 + F.lane * 8); }
#pragma unroll
        for (int r = 0; r < R; ++r) {
            float d[8]; float ss = 0.f;
#pragma unroll
            for (int i = 0; i < 8; ++i) { d[i] = bf2f(a[r][i]) - lam * bf2f(bq[r][i]); ss += d[i] * d[i]; }
            ss += __shfl_xor(ss, 1); ss += __shfl_xor(ss, 2); ss += __shfl_xor(ss, 4); ss += __shfl_xor(ss, 8);
            const float rstd = 1.0f / sqrtf(ss * (1.f / 128.f) + EPSN);
            v4u o; o.x = pk2(d[0] * rstd * gv[0], d[1] * rstd * gv[1]); o.y = pk2(d[2] * rstd * gv[2], d[3] * rstd * gv[3]);
            o.z = pk2(d[4] * rstd * gv[4], d[5] * rstd * gv[5]); o.w = pk2(d[6] * rstd * gv[6], d[7] * rstd * gv[7]);
            *(v4u*)(AO + (size_t)(m0 + r) * 1024 + F.lane * 8) = o;
        }
    }
}

__device__ __forceinline__ void p6_fill(Frame& F) {
    LAS float* wT = (LAS float*)F.lds;
    const float* rw = F.in[I_ROUTW];
    { float tmp[32];
#pragma unroll
        for (int i = 0; i < 32; ++i) tmp[i] = rw[F.tid + 512 * i];
#pragma unroll
        for (int i = 0; i < 32; ++i) { const int idx = F.tid + 512 * i, k = idx >> 4, j = idx & 15; wT[j * 1024 + k] = tmp[i]; } }
}
__device__ __forceinline__ void p6_rows(Frame& F) {
    LAS float* wT = (LAS float*)F.lds;
    const bf16* x1 = (const bf16*)(F.ws + WS_X1); const float* gm = F.in[I_GFFN]; const float* MOD = (const float*)(F.ws + WS_MOD);
    unsigned char* H2 = F.ws + WS_H2; float* AFF = (float*)(F.ws + WS_AFF);
    const int gw = F.vcu * NWAVES + F.wave, NGW = F.G * NWAVES;
    constexpr int R = 4;
    for (int m0 = gw * R; m0 < MTOK; m0 += NGW * R) {
        const int b = m0 >> 11, t0 = m0 & 2047;
        f32x4 v[R][4]; float ss[R];
#pragma unroll
        for (int r = 0; r < R; ++r) { const GAS v2u* xr = (const GAS v2u*)(x1 + (size_t)(m0 + r) * 1024) + F.lane;
#pragma unroll
            for (int j = 0; j < 4; ++j) { const v2u y = __builtin_nontemporal_load(xr + 64 * j);
                v[r][j] = (f32x4){__builtin_bit_cast(float, y.x << 16), __builtin_bit_cast(float, y.x & 0xffff0000u), __builtin_bit_cast(float, y.y << 16), __builtin_bit_cast(float, y.y & 0xffff0000u)}; } }
#pragma unroll
        for (int r = 0; r < R; ++r) { float t = 0.f;
#pragma unroll
            for (int j = 0; j < 4; ++j) t += (v[r][j].x * v[r][j].x + v[r][j].y * v[r][j].y) + (v[r][j].z * v[r][j].z + v[r][j].w * v[r][j].w);
            ss[r] = t; }
#pragma unroll
        for (int o = 1; o < 64; o <<= 1) {
#pragma unroll
            for (int r = 0; r < R; ++r) ss[r] += __shfl_xor(ss[r], o); }
#pragma unroll
        for (int r = 0; r < R; ++r) ss[r] = 1.0f / sqrtf(ss[r] * (1.f / 1024.f) + EPSN);
#pragma unroll
        for (int j = 0; j < 4; ++j) { const int col = 256 * j + 4 * F.lane;
            const f32x4 g = *(const f32x4*)(gm + col), sh = *(const f32x4*)(MOD + b * 6144 + 3072 + col), sc = *(const f32x4*)(MOD + b * 6144 + 4096 + col);
#pragma unroll
            for (int r = 0; r < R; ++r) { v[r][j] = (v[r][j] * ss[r] * g) * (sc + 1.0f) + sh;
                ((GAS unsigned*)(H2 + (size_t)(m0 + r) * 1024) + F.lane)[64 * j] = pg8::pk_fp8x4(v[r][j].x, v[r][j].y, v[r][j].z, v[r][j].w); } }
#pragma unroll
        for (int r = 0; r < R; r += 2) {
            float p[16], q[16];
#pragma unroll
            for (int jj = 0; jj < 16; ++jj) { float t = 0.f, u = 0.f;
#pragma unroll
                for (int j = 0; j < 4; ++j) { const f32x4 w = *(const LAS f32x4*)(wT + jj * 1024 + 256 * j + 4 * F.lane);
                    t += (v[r][j].x * w.x + v[r][j].y * w.y) + (v[r][j].z * w.z + v[r][j].w * w.w); u += (v[r + 1][j].x * w.x + v[r + 1][j].y * w.y) + (v[r + 1][j].z * w.z + v[r + 1][j].w * w.w); }
                p[jj] = t; q[jj] = u; if ((jj & 3) == 3) asm volatile("" ::: "memory"); }
            const float lgs[2] = {reduce16(p, F.lane), reduce16(q, F.lane)};
#pragma unroll
            for (int rr = 0; rr < 2; ++rr) {
                const float lg = lgs[rr];
                float mx = lg;
                mx = fmaxf(mx, __shfl_xor(mx, 4)); mx = fmaxf(mx, __shfl_xor(mx, 8)); mx = fmaxf(mx, __shfl_xor(mx, 16)); mx = fmaxf(mx, __shfl_xor(mx, 32));
                const float ex = expf(lg - mx); float sm = ex;
                sm += __shfl_xor(sm, 4); sm += __shfl_xor(sm, 8); sm += __shfl_xor(sm, 16); sm += __shfl_xor(sm, 32);
                if ((F.lane & 3) == 0) AFF[((size_t)(b * NE + reduce16_index(F.lane))) * SEQL + t0 + r + rr] = ex / sm;
            }
        }
    }
}

__device__ __forceinline__ void topk_task(Frame& F, int pm) {
    const float* AFF = (const float*)(F.ws + WS_AFF); int* IDX = (int*)(F.ws + WS_IDX); float* GATE = (float*)(F.ws + WS_GATE); int* SLOT = (int*)(F.ws + WS_SLOT);
    const int b = pm & 7, e = pm >> 3, task = b * NE + e;
    unsigned v[32];
#pragma unroll
    for (int i = 0; i < 32; ++i) v[i] = __builtin_bit_cast(unsigned, AFF[(size_t)task * SEQL + i * 64 + F.lane]);
    unsigned T = 0u;
    for (int bit = 30; bit >= 0; --bit) { const unsigned cand = T | (1u << bit); int c = 0;
#pragma unroll
        for (int i = 0; i < 32; ++i) c += (v[i] >= cand) ? 1 : 0;
        int cnt = 0;
#pragma unroll
        for (int bb = 0; bb < 6; ++bb) cnt += __popcll(__ballot((c >> bb) & 1)) << bb;
        if (cnt >= CAP) T = cand; }
    int cgt = 0;
#pragma unroll
    for (int i = 0; i < 32; ++i) cgt += __popcll(__ballot(v[i] > T));
    const int need = CAP - cgt;
    const unsigned long long lt = (1ull << F.lane) - 1ull;
    int running = 0, eqrun = 0;
#pragma unroll
    for (int i = 0; i < 32; ++i) {
        const bool gt = v[i] > T, eq = v[i] == T;
        const unsigned long long eqm = __ballot(eq);
        const int eqrank = eqrun + __popcll(eqm & lt);
        const bool sel = gt || (eq && eqrank < need);
        const unsigned long long sm = __ballot(sel);
        const int slot = running + __popcll(sm & lt), t = i * 64 + F.lane;
        if (sel) { IDX[pm * CAP + slot] = b * SEQL + t; GATE[pm * CAP + slot] = __builtin_bit_cast(float, v[i]); }
        SLOT[(size_t)(b * SEQL + t) * NE + e] = sel ? pm * CAP + slot : -1;
        running += __popcll(sm); eqrun += __popcll(eqm);
    }
}
template <class Sched> __device__ __forceinline__ void topk_for_units(Frame& F, const Sched& S) {
    pg8::Unit u; int prev = -1, nt = 0;
    for (int i = 0; S.next(i, u); ++i) { if (u.pm != prev) { if ((nt & 7) == F.wave) topk_task(F, u.pm); prev = u.pm; ++nt; } }
    VM_WAIT(); __syncthreads();
}

__device__ __forceinline__ void p10_rows(Frame& F) {
    const bf16* x1 = (const bf16*)(F.ws + WS_X1); float* outp = F.out; const float* gf = F.in[I_GFIN]; const float* MOD = (const float*)(F.ws + WS_MOD);
    const unsigned char* Y = F.ws + WS_Y; const int* SLOT = (const int*)(F.ws + WS_SLOT);
    const int gw = F.vcu * NWAVES + F.wave, NGW = F.G * NWAVES;
    constexpr int R = 2;
    int sln[R]; v2u xn[R][4];
#define P10_FETCH(M0) do { _Pragma("unroll") for (int r = 0; r < R; ++r) { sln[r] = SLOT[(size_t)((M0) + r) * NE + (F.lane & 15)]; const GAS v2u* xr = (const GAS v2u*)(x1 + (size_t)((M0) + r) * 1024) + F.lane; \
        _Pragma("unroll") for (int j = 0; j < 4; ++j) xn[r][j] = __builtin_nontemporal_load(xr + 64 * j); } } while (0)
    if (gw * R < MTOK) P10_FETCH(gw * R);
    for (int m0 = gw * R; m0 < MTOK; m0 += NGW * R) {
        const int b = m0 >> 11;
        int sl[R]; unsigned mk[R]; v2u xc[R][4];
#pragma unroll
        for (int r = 0; r < R; ++r) { sl[r] = sln[r];
#pragma unroll
            for (int j = 0; j < 4; ++j) xc[r][j] = xn[r][j]; }
        f32x4 v[R][4], a[R][4];
#pragma unroll
        for (int r = 0; r < R; ++r) mk[r] = (unsigned)__ballot(sl[r] >= 0) & 0xffffu;
        unsigned y[R][4][4]; float wq[R][4];
#pragma unroll
        for (int r = 0; r < R; ++r)
#pragma unroll
            for (int q = 0; q < 4; ++q) { const bool has = mk[r] != 0u; const int e = has ? __builtin_ctz(mk[r]) : 0; mk[r] &= mk[r] - 1u;
                const int srow = has ? __builtin_amdgcn_readlane(sl[r], e) : 0; wq[r][q] = has ? pg8::WSCALE_INV : 0.f; if (!has) mk[r] = 0u;
                const GAS unsigned* yr = (const GAS unsigned*)(Y + (size_t)srow * 1024) + F.lane;
#pragma unroll
                for (int j = 0; j < 4; ++j) y[r][q][j] = __builtin_nontemporal_load(yr + 64 * j); }
        asm volatile("" ::: "memory");
        if (m0 + NGW * R < MTOK) P10_FETCH(m0 + NGW * R);
#pragma unroll
        for (int r = 0; r < R; ++r)
#pragma unroll
            for (int j = 0; j < 4; ++j) { const v2u y0 = xc[r][j];
                v[r][j] = (f32x4){__builtin_bit_cast(float, y0.x << 16), __builtin_bit_cast(float, y0.x & 0xffff0000u), __builtin_bit_cast(float, y0.y << 16), __builtin_bit_cast(float, y0.y & 0xffff0000u)};
                a[r][j] = (f32x4){0.f, 0.f, 0.f, 0.f}; }
#pragma unroll
        for (int r = 0; r < R; ++r)
#pragma unroll
            for (int q = 0; q < 4; ++q)
#pragma unroll
                for (int j = 0; j < 4; ++j) { const unsigned yy = y[r][q][j]; const float w = wq[r][q];
                    const auto lo = __builtin_amdgcn_cvt_pk_f32_fp8((int)yy, false), hi = __builtin_amdgcn_cvt_pk_f32_fp8((int)yy, true);
                    a[r][j].x += w * lo[0]; a[r][j].y += w * lo[1]; a[r][j].z += w * hi[0]; a[r][j].w += w * hi[1]; }
#pragma unroll
        for (int r = 0; r < R; ++r) while (mk[r] != 0u) { const int e = __builtin_ctz(mk[r]); mk[r] &= mk[r] - 1u; const int srow = __builtin_amdgcn_readlane(sl[r], e);
            const GAS unsigned* yr = (const GAS unsigned*)(Y + (size_t)srow * 1024) + F.lane;
#pragma unroll
            for (int j = 0; j < 4; ++j) { const unsigned yy = yr[64 * j];
                const auto lo = __builtin_amdgcn_cvt_pk_f32_fp8((int)yy, false), hi = __builtin_amdgcn_cvt_pk_f32_fp8((int)yy, true);
                a[r][j].x += pg8::WSCALE_INV * lo[0]; a[r][j].y += pg8::WSCALE_INV * lo[1]; a[r][j].z += pg8::WSCALE_INV * hi[0]; a[r][j].w += pg8::WSCALE_INV * hi[1]; } }
        float ss[R];
#pragma unroll
        for (int r = 0; r < R; ++r) ss[r] = 0.f;
#pragma unroll
        for (int j = 0; j < 4; ++j) { const int col = 256 * j + 4 * F.lane; const f32x4 g2 = *(const f32x4*)(MOD + b * 6144 + 5120 + col);
#pragma unroll
            for (int r = 0; r < R; ++r) { v[r][j] = v[r][j] + g2 * a[r][j]; ss[r] += (v[r][j].x * v[r][j].x + v[r][j].y * v[r][j].y) + (v[r][j].z * v[r][j].z + v[r][j].w * v[r][j].w); } }
#pragma unroll
        for (int o = 1; o < 64; o <<= 1) {
#pragma unroll
            for (int r = 0; r < R; ++r) ss[r] += __shfl_xor(ss[r], o); }
#pragma unroll
        for (int j = 0; j < 4; ++j) { const int col = 256 * j + 4 * F.lane; const f32x4 g = *(const f32x4*)(gf + col);
#pragma unroll
            for (int r = 0; r < R; ++r) { const float rstd = 1.0f / sqrtf(ss[r] * (1.f / 1024.f) + EPSN); __builtin_nontemporal_store(v[r][j] * rstd * g, (GAS f32x4*)(outp + (size_t)(m0 + r) * 1024) + F.lane + 64 * j); } }
    }
}

struct Args { const float* in[27]; float* out; unsigned char* ws; int ph_lo, ph_hi; };
__global__ void __launch_bounds__(NWAVES * 64, 2) mk_fwd(Args args) {
    extern __shared__ __attribute__((aligned(16))) unsigned char lds[];
    Frame F;
    F.lds = (LAS unsigned char*)lds;
    F.MISC = (volatile LAS unsigned*)(F.lds + MISC_OFF);
    F.tid = threadIdx.x; F.lane = F.tid & 63; F.wave = __builtin_amdgcn_readfirstlane(F.tid >> 6);
    F.G = gridDim.x; { const int bx = blockIdx.x; F.vcu = (F.G % 8 == 0) ? (bx % 8) * (F.G / 8) + bx / 8 : bx; }
#pragma unroll
    for (int i = 0; i < 27; ++i) F.in[i] = args.in[i];
    F.out = args.out; F.ws = args.ws; F.ctl = (gu32*)(args.ws + WS_CTL);
    for (int u = F.tid; u < (LDS_BYTES - LDSCTL_OFF) / 4; u += NWAVES * 64) ((LAS unsigned*)(F.lds + LDSCTL_OFF))[u] = 0u;
    __syncthreads();
    XcdBarrier bar; bar.bar = (unsigned*)(F.ctl + CW_BAR); bar.x = 0; bar.st = nullptr;
    if (N_LAUNCHES != PER_PHASE) bar = xcd_barrier_post((unsigned*)(F.ctl + CW_BAR), F.MISC + 8);
    const int lo = args.ph_lo, hi = args.ph_hi;
#ifndef PH_MASK
#define PH_MASK 0x7ff
#endif
#define IN(k) (((PH_MASK >> (k)) & 1) && lo <= (k) && (k) < hi)
#define SEAM(k) do { if (IN(k) && IN((k) + 1)) xcd_barrier(bar); } while (0)

    BgConv bg;
    if (IN(0)) { p0_prologue(F); SEAM(0); }
    if (IN(1)) { p1_rows(F); SEAM(1); }
    if (IN(2)) {
        pg8::Gemm g{F.ws + WS_XN, F.ws + WS_WIN, 2048}; pg8::StaticOrder S; S.init(MTOK, 3072, F.G, (int)blockIdx.x);
        pg8::EpiP E{(bf16*)(F.ws + WS_P), NPC, 2, 0.125f * LOG2E, (float*)(F.ws + WS_DTRAW)}; pg8::ARowDense AR;
        pg8::gemm_phase<pg8::EpiP, pg8::StaticOrder, pg8::ARowDense, true, false>(F.lds + RING_OFF, g, S, E, AR);
        if (IN(3)) { xcd_arrive(bar); bg.init(F); xcd_wait(bar); }
    }
    if (IN(3)) {
        const float* TAB = (const float*)(F.ws + WS_TAB);
        const attn2::bf16* P = (const attn2::bf16*)(F.ws + WS_P); attn2::bf16* AORAW = (attn2::bf16*)(F.ws + WS_AORAW);
#ifndef NO_ATTN
        if (!IN(2)) bg.init(F);
        int hprev = -1; float clo = 0.f, chi = 0.f;
        __syncthreads();
        for (int u = F.vcu; u < 512; u += F.G) {
            const int bhm = u >> 3, qb = u & 7, b = bhm >> 3, h = (bhm >> 1) & 3, mp = bhm & 1;
            const float* tabsrc = nullptr;
            if (h != hprev) {
                tabsrc = TAB + h * 4096 - 256 + 2047; hprev = h;
                clo = __builtin_bit_cast(float, __builtin_amdgcn_readfirstlane(__builtin_bit_cast(int, TAB[h * 4096]))); chi = __builtin_bit_cast(float, __builtin_amdgcn_readfirstlane(__builtin_bit_cast(int, TAB[h * 4096 + 4094]))); }
            const size_t rowb = (size_t)b * SEQL;
            attn2::attn_unit(P + (rowb + qb * 256) * NPC + QOFF + h * 128 + mp * 64, P + rowb * NPC + KOFF + h * 128 + mp * 64, P + rowb * NPC + VOFF + h * 128,
                             AORAW + (size_t)mp * MTOK * 512 + (rowb + qb * 256) * 512 + h * 128, qb, (char*)lds + RING_OFF, tabsrc, clo, chi, bg);
        }
        bg.drain();
#endif
        __syncthreads();
#ifndef NO_SSDA
        for (int u = F.vcu; u < 256; u += F.G) ssd_a_unit(F, u >> 5, (u >> 1) & 15, u & 1);
#endif
        SEAM(3);
    }
    if (IN(4)) { ps_scan(F); attn_finalize_rows(F); if (IN(5)) xcd_arrive(bar); }
    if (IN(5)) {
        { bool pend = IN(4); for (int u = F.vcu; u < 256; u += F.G) { ssd_b_unit(F, u >> 5, (u >> 1) & 15, u & 1, bar, pend); pend = false; } if (pend) xcd_wait(bar); }
        SEAM(5);
    }
    if (IN(6)) {
        pg8::Gemm g{F.ws + WS_AO, F.ws + WS_WOUT, 2048}; pg8::StaticOrder S; S.init(MTOK, 1024, F.G, (int)blockIdx.x);
        pg8::EpiX1 E{F.in[I_X], (bf16*)(F.ws + WS_X1), (const float*)(F.ws + WS_MOD)}; pg8::ARowDense AR;
        pg8::gemm_phase<pg8::EpiX1, pg8::StaticOrder, pg8::ARowDense, true, false>(F.lds + RING_OFF, g, S, E, AR);
        if (IN(7)) { xcd_arrive(bar); p6_fill(F); xcd_wait(bar); }
    }
    if (IN(7)) { if (!IN(6)) { p6_fill(F); __syncthreads(); } p6_rows(F); SEAM(7); }
    if (IN(8)) {
        pg8::Gemm g{F.ws + WS_H2, F.ws + WS_WGU, 1024}; pg8::MoeOrder<22> S{F.G, F.vcu};
        pg8::EpiHid E{F.ws + WS_HID}; pg8::ARowGather AR{(const int*)(F.ws + WS_IDX)};
        topk_for_units(F, S);
        pg8::gemm_phase<pg8::EpiHid, pg8::MoeOrder<22>, pg8::ARowGather, true, true>(F.lds + RING_OFF, g, S, E, AR);
        SEAM(8);
    }
    if (IN(9)) {
        pg8::Gemm g{F.ws + WS_HID, F.ws + WS_WD, FFD}; pg8::MoeOrder<4> S{F.G, F.vcu};
        pg8::EpiY E{F.ws + WS_Y, (const float*)(F.ws + WS_GATE)}; pg8::ARowDenseVO AR;
        pg8::gemm_phase<pg8::EpiY, pg8::MoeOrder<4>, pg8::ARowDenseVO, true, true>(F.lds + RING_OFF, g, S, E, AR);
        SEAM(9);
    }
    if (IN(10)) { p10_rows(F); }
#undef IN
#undef SEAM
}

extern "C" void kernel_launch(void* const* d_in, const int* in_sizes, int n_in, void* d_out, int out_size, void* d_ws, size_t ws_size, hipStream_t stream) {
    static int grid = 0;
    if (grid == 0) {
        if (n_in != 27 || in_sizes[0] != MTOK * DMODEL || out_size != MTOK * DMODEL || ws_size < WS_END) {
            fprintf(stderr, "kernel_launch: unexpected shapes: n_in %d, in0 %d, out %d, ws %zu (need %zu); nothing launched\n", n_in, n_in > 0 ? in_sizes[0] : -1, out_size, ws_size, (size_t)WS_END); grid = -1; return; }
        int dev = 0, cus = 0, per_cu = 0;
        if (hipGetDevice(&dev) != hipSuccess || hipDeviceGetAttribute(&cus, hipDeviceAttributeMultiprocessorCount, dev) != hipSuccess) { grid = -1; return; }
        if (hipFuncSetAttribute((const void*)mk_fwd, hipFuncAttributeMaxDynamicSharedMemorySize, LDS_BYTES) != hipSuccess) { fprintf(stderr, "kernel_launch: hipFuncSetAttribute failed\n"); grid = -1; return; }
        if (hipOccupancyMaxActiveBlocksPerMultiprocessor(&per_cu, (const void*)mk_fwd, NWAVES * 64, LDS_BYTES) != hipSuccess || per_cu < 1) { fprintf(stderr, "kernel_launch: occupancy query says %d\n", per_cu); per_cu = 1; }
        (void)hipGetLastError();
        grid = cus;
        if (grid > 256) grid = 256;
    }
    if (grid < 0) return;
    (void)hipMemsetAsync((char*)d_ws + WS_CTL, 0, CTL_ZERO_BYTES, stream);
    Args a{};
    for (int i = 0; i < 27; ++i) a.in[i] = (const float*)d_in[i];
    a.out = (float*)d_out; a.ws = (unsigned char*)d_ws;
    if (N_LAUNCHES == 1) { a.ph_lo = 0; a.ph_hi = PER_PHASE; hipLaunchKernelGGL(mk_fwd, dim3(grid), dim3(NWAVES * 64), LDS_BYTES, stream, a); }
    else { for (int li = 0; li < PER_PHASE; ++li) { a.ph_lo = li; a.ph_hi = li + 1; hipLaunchKernelGGL(mk_fwd, dim3(grid), dim3(NWAVES * 64), LDS_BYTES, stream, a); } }
}
```
